# Optimizing an MI355X kernel written in HIP

```python
import math
import jax, jax.numpy as jnp
from jax import lax
import numpy as np


D_MODEL = 1024
BATCH = 4
SEQ = 8192
DEPTH = 2

GRID_W = 64
CTX_LEN = 256
CHUNK = 128
Q_BLOCK = 128
NORM_EPS = 1e-6
ROPE_THETA = 10000.0

SSD_HEADS = 16
SSD_HEAD_DIM = 64
SSD_INNER = SSD_HEADS * SSD_HEAD_DIM
SSD_GROUPS = 2
SSD_STATE = 128
SSD_CONV = 3
SSD_CONV_CH = SSD_INNER + 2 * SSD_GROUPS * SSD_STATE
RET_HEADS = 4
RET_QK_DIM = 128
RET_V_DIM = 256
RET_QK = RET_HEADS * RET_QK_DIM
RET_INNER = RET_HEADS * RET_V_DIM
EVEN_IN = SSD_INNER + SSD_CONV_CH + 2 * SSD_HEADS + 2 * RET_QK + 2 * RET_INNER
EVEN_MIX = SSD_INNER + RET_INNER
DIFF_HEADS = 8
DIFF_HEAD_DIM = 64
DIFF_V_DIM = 2 * DIFF_HEAD_DIM
DIFF_INNER = DIFF_HEADS * DIFF_V_DIM
ODD_IN = 3 * DIFF_INNER
FFN_DENSE = 2816
N_EXPERTS = 8
TOP_K = 2
FFN_EXPERT = 3584

kernel_name = "hybrid_ssd_retention_diffattn_moe_dit"


def rms_norm(x, gain=None):
    xf = x.astype(jnp.float32)
    y = xf * lax.rsqrt(jnp.mean(xf * xf, axis=-1, keepdims=True) + NORM_EPS)
    if gain is not None:
        y = y * gain.astype(jnp.float32)
    return y.astype(x.dtype)


def adaln(cond, w, b):
    m = jax.nn.silu(cond) @ w + b
    return jnp.split(m[..., None, :], 6, axis=-1)


def modulate(x, gain, shift, scale):
    return rms_norm(x, gain) * (1 + scale) + shift


def rope_angles(pos, dim, theta):
    inv = theta ** (-jnp.arange(dim // 2, dtype=jnp.float32) / (dim // 2))
    return pos.astype(jnp.float32)[:, None] * inv[None, :]


def apply_rope(x, ang):
    half = x.shape[-1] // 2
    shape = (1, ang.shape[0]) + (1,) * (x.ndim - 3) + (half,)
    cos = jnp.cos(ang).reshape(shape).astype(x.dtype)
    sin = jnp.sin(ang).reshape(shape).astype(x.dtype)
    x1, x2 = x[..., :half], x[..., half:]
    return jnp.concatenate([x1 * cos - x2 * sin, x1 * sin + x2 * cos], axis=-1)


def rope_2d(x, ang_row, ang_col):
    half = x.shape[-1] // 2
    return jnp.concatenate([apply_rope(x[..., :half], ang_row), apply_rope(x[..., half:], ang_col)], axis=-1)


def dwconv_centred(x, w, b):
    K, C = w.shape
    y = lax.conv_general_dilated(x, w[:, None, :].astype(x.dtype), window_strides=(1,),
                                 padding=[(K // 2, K // 2)], dimension_numbers=('NWC', 'WIO', 'NWC'),
                                 feature_group_count=C)
    return y + b


def chunked_scan(q, k, v, log_a, h0):
    Bsz, L, G, N = q.shape
    R, P = v.shape[-2:]
    nc = L // CHUNK
    qc = q.reshape(Bsz, nc, CHUNK, G, N)
    kc = k.reshape(Bsz, nc, CHUNK, G, N)
    vc = v.reshape(Bsz, nc, CHUNK, G, R, P)
    a_cs = jnp.cumsum(log_a.astype(jnp.float32).reshape(Bsz, nc, CHUNK, G, R), axis=2)
    idx = jnp.arange(CHUNK)
    causal = (idx[:, None] >= idx[None, :])[:, :, None, None]
    diff = a_cs[:, :, :, None] - a_cs[:, :, None, :]
    decay = jnp.exp(jnp.where(causal, diff, -jnp.inf))
    scores = jnp.einsum('bclgn,bcsgn->bclsg', qc, kc)
    y_diag = jnp.einsum('bclsgr,bcsgrp->bclgrp', scores[..., None] * decay, vc)
    to_end = jnp.exp(a_cs[:, :, -1:] - a_cs)
    states = jnp.einsum('bcsgn,bcsgrp->bcgrpn', kc, vc * to_end[..., None])
    a_tot = jnp.exp(a_cs[:, :, -1])

    def step(h, inp):
        s_c, g_c = inp
        return h * g_c[..., None, None] + s_c, h

    h_fin, h_in = lax.scan(step, h0.astype(jnp.float32), (jnp.moveaxis(states, 1, 0), jnp.moveaxis(a_tot, 1, 0)))
    h_in = jnp.moveaxis(h_in, 0, 1)
    y_off = jnp.einsum('bclgn,bcgrpn->bclgrp', qc, h_in) * jnp.exp(a_cs)[..., None]
    y = (y_diag + y_off).reshape(Bsz, L, G, R, P)
    return y.astype(v.dtype), h_fin


def bidir_scan(q, k, v_f, v_b, la_f, la_b, h0_f, h0_b):
    y_f, h_f = chunked_scan(q, k, v_f, la_f, h0_f)
    flip = lambda t: jnp.flip(t, axis=1)
    y_b, h_b = chunked_scan(flip(q), flip(k), flip(v_b), flip(la_b), h0_b)
    return y_f + flip(y_b), h_f, h_b


def even_prepare(h, ang, w_in, conv_w, conv_b, dt_bias, a_log, ret_decay):
    Bsz, L, _ = h.shape
    G, R = SSD_GROUPS, SSD_HEADS // SSD_GROUPS
    cuts = np.cumsum([SSD_INNER, SSD_CONV_CH, 2 * SSD_HEADS, RET_QK, RET_QK, RET_INNER]).tolist()
    z, xbc, dt, rq, rk, rv, rg = jnp.split(h @ w_in, cuts, axis=-1)
    xbc = jax.nn.silu(dwconv_centred(xbc, conv_w, conv_b))
    xs, bm, cm = jnp.split(xbc, [SSD_INNER, SSD_INNER + SSD_GROUPS * SSD_STATE], axis=-1)
    xs = xs.reshape(Bsz, L, G, R, SSD_HEAD_DIM)
    bm = bm.reshape(Bsz, L, G, SSD_STATE)
    cm = cm.reshape(Bsz, L, G, SSD_STATE)
    dt = jax.nn.softplus((dt.reshape(Bsz, L, 2, SSD_HEADS) + dt_bias).astype(jnp.float32))
    log_a = (dt * -jnp.exp(a_log.astype(jnp.float32))).reshape(Bsz, L, 2, G, R)
    xdt = xs[:, :, None] * dt.reshape(Bsz, L, 2, G, R, 1).astype(xs.dtype)
    ssd = (cm, bm, xdt[:, :, 0], xdt[:, :, 1], log_a[:, :, 0], log_a[:, :, 1])
    rq = apply_rope(rq.reshape(Bsz, L, RET_HEADS, RET_QK_DIM), ang)
    rk = apply_rope(rk.reshape(Bsz, L, RET_HEADS, RET_QK_DIM), ang) * (RET_QK_DIM ** -0.5)
    rv = rv.reshape(Bsz, L, RET_HEADS, 1, RET_V_DIM)
    rla = jnp.broadcast_to(-jnp.exp(ret_decay.astype(jnp.float32))[:, None, None, :, None],
                           (2, Bsz, L, RET_HEADS, 1))
    ret = (rq, rk, rv, rv, rla[0], rla[1])
    return ssd, ret, xs, z, rg


def even_finish(ssd_y, ret_y, xs, z, rg, d_skip, ssd_norm, w_out):
    Bsz, L = z.shape[:2]
    y = ssd_y + xs * d_skip.reshape(SSD_GROUPS, -1, 1)
    y = rms_norm(y.reshape(Bsz, L, SSD_INNER) * jax.nn.silu(z), ssd_norm)
    r = rms_norm(ret_y.reshape(Bsz, L, RET_HEADS, RET_V_DIM)).reshape(Bsz, L, RET_INNER) * jax.nn.silu(rg)
    return jnp.concatenate([y, r], axis=-1) @ w_out


def odd_qkv(h, w_in, q_norm, k_norm, ang_row=None, ang_col=None):
    Bsz, L, _ = h.shape
    q, k, v = jnp.split(h @ w_in, 3, axis=-1)
    q = rms_norm(q.reshape(Bsz, L, DIFF_HEADS, 2, DIFF_HEAD_DIM), q_norm)
    k = rms_norm(k.reshape(Bsz, L, DIFF_HEADS, 2, DIFF_HEAD_DIM), k_norm)
    if ang_row is not None:
        q = rope_2d(q, ang_row, ang_col)
        k = rope_2d(k, ang_row, ang_col)
    return q * (DIFF_HEAD_DIM ** -0.5), k, v.reshape(Bsz, L, DIFF_HEADS, DIFF_V_DIM)


def diff_attend(q, k, v, lam):
    s = jnp.einsum('bqhmd,bkhmd->bhmqk', q, k).astype(jnp.float32)
    p = jax.nn.softmax(s, axis=-1)
    a = p[:, :, 0] - lam.astype(jnp.float32) * p[:, :, 1]
    return jnp.einsum('bhqk,bkhe->bqhe', a.astype(v.dtype), v)


def diff_out(o, lam_init, subln, w_out):
    Bsz, L = o.shape[:2]
    o = rms_norm(o, subln) * (1.0 - lam_init)
    return o.reshape(Bsz, L, DIFF_INNER) @ w_out


def swiglu(h, w_gate, w_up, w_down):
    return (jax.nn.silu(h @ w_gate) * (h @ w_up)) @ w_down


def moe(h, w_router, w_gate, w_up, w_down):
    logits = (h @ w_router).astype(jnp.float32)
    top_val, top_idx = lax.top_k(logits, TOP_K)
    top_w = jax.nn.softmax(top_val, axis=-1)
    combine = jnp.sum(jax.nn.one_hot(top_idx, N_EXPERTS, dtype=jnp.float32) * top_w[..., None], axis=-2)
    out = jnp.zeros_like(h)
    for e in range(N_EXPERTS):
        out = out + combine[..., e:e + 1].astype(h.dtype) * swiglu(h, w_gate[e], w_up[e], w_down[e])
    return out


def setup_inputs(seed: int = 0) -> dict:
    key = jax.random.key(seed)
    ks = iter(jax.random.split(key, 64))
    f32 = jnp.float32
    D = D_MODEL
    ne, no = (DEPTH + 1) // 2, DEPTH // 2

    def nrm(shape, scale):
        return jax.random.normal(next(ks), shape, f32) * scale

    def gain(shape):
        return 1.0 + nrm(shape, 0.01)

    x = nrm((BATCH, SEQ, D), 1.0)
    c = nrm((BATCH, D), 1.0)
    ctx = nrm((BATCH, CTX_LEN, D), 1.0)
    c_ctx = nrm((D,), 1.0)
    u = jax.random.uniform(next(ks), (ne, 2, SSD_HEADS), f32)
    dt0 = jnp.exp(u * (math.log(0.1) - math.log(0.001)) + math.log(0.001))
    gam = 1.0 - 2.0 ** (-5.0 - jnp.arange(RET_HEADS, dtype=f32))
    return {
        "x": x, "c": c, "ctx": ctx, "c_ctx": c_ctx,
        "even_w_mod": nrm((ne, D, 6 * D), 0.5 * D ** -0.5),
        "even_b_mod": nrm((ne, 6 * D), 0.01),
        "even_norm1": gain((ne, D)),
        "even_norm2": gain((ne, D)),
        "even_w_in": nrm((ne, D, EVEN_IN), D ** -0.5),
        "even_conv_w": nrm((ne, SSD_CONV, SSD_CONV_CH), SSD_CONV ** -0.5),
        "even_conv_b": nrm((ne, SSD_CONV_CH), 0.01),
        "even_dt_bias": dt0 + jnp.log(-jnp.expm1(-dt0)),
        "even_a_log": jnp.log(jax.random.uniform(next(ks), (ne, 2, SSD_HEADS), f32, 1.0, 16.0)),
        "even_d": gain((ne, SSD_HEADS)),
        "even_ssd_norm": gain((ne, SSD_INNER)),
        "even_ret_decay": jnp.log(-jnp.log(gam)) + nrm((ne, 2, RET_HEADS), 0.05),
        "even_w_out": nrm((ne, EVEN_MIX, D), EVEN_MIX ** -0.5),
        "even_ffn_gate": nrm((ne, D, FFN_DENSE), D ** -0.5),
        "even_ffn_up": nrm((ne, D, FFN_DENSE), D ** -0.5),
        "even_ffn_down": nrm((ne, FFN_DENSE, D), FFN_DENSE ** -0.5),
        "odd_w_mod": nrm((no, D, 6 * D), 0.5 * D ** -0.5),
        "odd_b_mod": nrm((no, 6 * D), 0.01),
        "odd_norm1": gain((no, D)),
        "odd_norm2": gain((no, D)),
        "odd_w_in": nrm((no, D, ODD_IN), D ** -0.5),
        "odd_q_norm": gain((no, DIFF_HEAD_DIM)),
        "odd_k_norm": gain((no, DIFF_HEAD_DIM)),
        "odd_lambda": nrm((no, 4, DIFF_HEAD_DIM), 0.1),
        "odd_subln": gain((no, DIFF_V_DIM)),
        "odd_w_out": nrm((no, DIFF_INNER, D), DIFF_INNER ** -0.5),
        "odd_router": nrm((no, D, N_EXPERTS), D ** -0.5),
        "odd_exp_gate": nrm((no, N_EXPERTS, D, FFN_EXPERT), D ** -0.5),
        "odd_exp_up": nrm((no, N_EXPERTS, D, FFN_EXPERT), D ** -0.5),
        "odd_exp_down": nrm((no, N_EXPERTS, FFN_EXPERT, D), FFN_EXPERT ** -0.5),
    }


def reference(x, c, ctx, c_ctx, even_w_mod, even_b_mod, even_norm1, even_norm2, even_w_in, even_conv_w,
              even_conv_b, even_dt_bias, even_a_log, even_d, even_ssd_norm, even_ret_decay, even_w_out,
              even_ffn_gate, even_ffn_up, even_ffn_down, odd_w_mod, odd_b_mod, odd_norm1, odd_norm2, odd_w_in,
              odd_q_norm, odd_k_norm, odd_lambda, odd_subln, odd_w_out, odd_router, odd_exp_gate, odd_exp_up,
              odd_exp_down):
    Bsz, L, _ = x.shape
    Lc = ctx.shape[1]
    n_rows = L // GRID_W
    row = jnp.broadcast_to(jnp.arange(n_rows)[:, None], (n_rows, GRID_W)).reshape(-1)
    col = jnp.broadcast_to(jnp.arange(GRID_W)[None, :], (n_rows, GRID_W)).reshape(-1)
    ang_row = rope_angles(row, DIFF_HEAD_DIM // 2, ROPE_THETA)
    ang_col = rope_angles(col, DIFF_HEAD_DIM // 2, ROPE_THETA)
    ang_ret_ctx = rope_angles(jnp.arange(Lc), RET_QK_DIM, ROPE_THETA)
    ang_ret_lat = rope_angles(Lc + jnp.arange(L), RET_QK_DIM, ROPE_THETA)
    zeros_ssd = jnp.zeros((Bsz, SSD_GROUPS, SSD_HEADS // SSD_GROUPS, SSD_HEAD_DIM, SSD_STATE), jnp.float32)
    zeros_ret = jnp.zeros((Bsz, RET_HEADS, 1, RET_V_DIM, RET_QK_DIM), jnp.float32)

    xl, xc = x, ctx
    for i in range(DEPTH):
        j = i // 2
        last = i == DEPTH - 1
        if i % 2 == 0:
            sh1, sc1, g1, sh2, sc2, g2 = adaln(c, even_w_mod[j], even_b_mod[j])
            csh1, csc1, cg1, csh2, csc2, cg2 = adaln(c_ctx, even_w_mod[j], even_b_mod[j])
            hl = modulate(xl, even_norm1[j], sh1, sc1)
            hc = modulate(xc, even_norm1[j], csh1, csc1)
            p_args = (even_w_in[j], even_conv_w[j], even_conv_b[j], even_dt_bias[j], even_a_log[j], even_ret_decay[j])
            ssd_c, ret_c, xs_c, z_c, rg_c = even_prepare(hc, ang_ret_ctx, *p_args)
            ssd_l, ret_l, xs_l, z_l, rg_l = even_prepare(hl, ang_ret_lat, *p_args)
            ys_c, hs_f, hs_b = bidir_scan(*ssd_c, zeros_ssd, zeros_ssd)
            yr_c, hr_f, hr_b = bidir_scan(*ret_c, zeros_ret, zeros_ret)
            ys_l, _, _ = bidir_scan(*ssd_l, hs_f, hs_b)
            yr_l, _, _ = bidir_scan(*ret_l, hr_f, hr_b)
            xl = xl + g1 * even_finish(ys_l, yr_l, xs_l, z_l, rg_l, even_d[j], even_ssd_norm[j], even_w_out[j])
            hl = modulate(xl, even_norm2[j], sh2, sc2)
            xl = xl + g2 * swiglu(hl, even_ffn_gate[j], even_ffn_up[j], even_ffn_down[j])
            if not last:
                xc = xc + cg1 * even_finish(ys_c, yr_c, xs_c, z_c, rg_c, even_d[j], even_ssd_norm[j], even_w_out[j])
                hc = modulate(xc, even_norm2[j], csh2, csc2)
                xc = xc + cg2 * swiglu(hc, even_ffn_gate[j], even_ffn_up[j], even_ffn_down[j])
        else:
            sh1, sc1, g1, sh2, sc2, g2 = adaln(c, odd_w_mod[j], odd_b_mod[j])
            csh1, csc1, cg1, csh2, csc2, cg2 = adaln(c_ctx, odd_w_mod[j], odd_b_mod[j])
            hl = modulate(xl, odd_norm1[j], sh1, sc1)
            hc = modulate(xc, odd_norm1[j], csh1, csc1)
            lam_init = 0.8 - 0.6 * math.exp(-0.3 * i)
            lq1, lk1, lq2, lk2 = odd_lambda[j]
            lam = jnp.exp(jnp.sum(lq1 * lk1)) - jnp.exp(jnp.sum(lq2 * lk2)) + lam_init
            q_c, k_c, v_c = odd_qkv(hc, odd_w_in[j], odd_q_norm[j], odd_k_norm[j])
            q_l, k_l, v_l = odd_qkv(hl, odd_w_in[j], odd_q_norm[j], odd_k_norm[j], ang_row, ang_col)
            k_all = jnp.concatenate([k_c, k_l], axis=1)
            v_all = jnp.concatenate([v_c, v_l], axis=1)
            nb = L // Q_BLOCK
            qb = jnp.moveaxis(q_l.reshape(Bsz, nb, Q_BLOCK, DIFF_HEADS, 2, DIFF_HEAD_DIM), 1, 0)
            ob = lax.map(lambda q_blk: diff_attend(q_blk, k_all, v_all, lam), qb)
            o_l = jnp.moveaxis(ob, 0, 1).reshape(Bsz, L, DIFF_HEADS, DIFF_V_DIM)
            xl = xl + g1 * diff_out(o_l, lam_init, odd_subln[j], odd_w_out[j])
            hl = modulate(xl, odd_norm2[j], sh2, sc2)
            xl = xl + g2 * moe(hl, odd_router[j], odd_exp_gate[j], odd_exp_up[j], odd_exp_down[j])
            if not last:
                o_c = diff_attend(q_c, k_c, v_c, lam)
                xc = xc + cg1 * diff_out(o_c, lam_init, odd_subln[j], odd_w_out[j])
                hc = modulate(xc, odd_norm2[j], csh2, csc2)
                xc = xc + cg2 * moe(hc, odd_router[j], odd_exp_gate[j], odd_exp_up[j], odd_exp_down[j])
    return xl
```

```cpp
#include <hip/hip_runtime.h>
#include <cstdio>
#include <cstdint>

#ifndef MK_N_LAUNCHES
#define MK_N_LAUNCHES 1
#endif

namespace pg8 {
#define PG8_LAS __attribute__((address_space(3)))
typedef unsigned short bf16_t;
typedef short bf16x8 __attribute__((ext_vector_type(8)));
typedef float f32x4 __attribute__((ext_vector_type(4)));
typedef unsigned u32x4 __attribute__((ext_vector_type(4)));
typedef unsigned u32x2 __attribute__((ext_vector_type(2)));
constexpr int BM = 256, BK = 64, HALF = 128, HTB = HALF * BK * 2  , STAGE_BYTES = 8 * HTB, NXCD = 8, WGM = 8;

__host__ __device__ __forceinline__ int lds_byte(int r, int c) { const int st = (r >> 4) * 2 + (c >> 5), rr = r & 15, cc = c & 31, ob = rr * 64 + cc * 2; return st * 1024 + (ob ^ (((ob >> 9) & 1) << 5)); }
__host__ __device__ __forceinline__ void stage_rc(int b, int& R, int& C) { const int st = b / 1024, sb = b % 1024, swz = sb ^ (((sb >> 9) & 1) << 5); R = (st >> 1) * 16 + swz / 64; C = (st & 1) * 32 + (swz % 64) / 2; }
__host__ __device__ __forceinline__ int perm32(int rho) { const int n = rho >> 4, i = rho & 15; return 8 * (i >> 2) + 4 * n + (i & 3); }

struct Unit { int pm, pn, kt0, nkt, split, tq, sl, nsl; };
struct Gemm { const bf16_t* A; const bf16_t* Bt; int M, N, K; };

struct StaticOrder {
    int nM, nN, nwg, G, c;
    __host__ __device__ void init(int M, int N, int G_, int c_) { nM = M / BM; nN = N / BM; nwg = nM * nN; G = G_; c = c_; }
    __host__ __device__ __forceinline__ bool next(int i, Unit& u) const {
        const long L = (long)i * G + c; if (L >= nwg) return false;
        int wgid = (int)L; { const int q = nwg / NXCD, r = nwg % NXCD, xcd = wgid % NXCD, off = wgid / NXCD; wgid = (xcd < r ? xcd * (q + 1) : r * (q + 1) + (xcd - r) * q) + off; }
        const int nig = WGM * nN, gid = wgid / nig, fm = gid * WGM, gsz = (nM - fm) < WGM ? (nM - fm) : WGM;
        u.pm = fm + ((wgid % nig) % gsz); u.pn = (wgid % nig) / gsz; u.kt0 = 0; u.nkt = 0; u.split = 0; u.tq = 0; u.sl = 0; u.nsl = 1; return true;
    }
    __host__ __device__ __forceinline__ int arow(const Unit& u) const { return u.pm; }
};
constexpr bool TAIL_SPLIT = false;
constexpr int TAIL_MAX_PARTS = 96;
struct TailSplit {
    int nsl, pairs_s, pairs;
    __device__ __forceinline__ void init(int r, int G, int nt, int cap) { pairs = nt >> 1; int sp = r > 0 ? G / r : 1; if (sp > cap) sp = cap; if (r > 0 && sp * r > TAIL_MAX_PARTS) sp = TAIL_MAX_PARTS / r; if (sp < 1) sp = 1; if (sp > pairs) sp = pairs; pairs_s = (pairs + sp - 1) / sp; nsl = (pairs + pairs_s - 1) / pairs_s; }
    __device__ __forceinline__ void slice(int s, int q, Unit& u) const { const int p0 = s * pairs_s, p1 = (p0 + pairs_s) < pairs ? (p0 + pairs_s) : pairs; u.kt0 = 2 * p0; u.nkt = 2 * (p1 - p0); u.split = nsl > 1 ? 1 : 0; u.tq = q; u.sl = s; u.nsl = nsl; }
};
struct MoeOrder {
    int nT, nN, G, c; const int* texp; int t0, shift, nL, H;
    __device__ __forceinline__ void init(int nT_, int nN_, int G_, int c_, const int* texp_, int t0_, int shift_, int nL_, int H_) {
        nT = nT_ < 0 ? 0 : nT_; nN = nN_; G = G_; c = c_; texp = texp_; t0 = t0_; shift = shift_; nL = (nL_ > 0 && nL_ < G_) ? nL_ : 0; H = H_; }
    __device__ __forceinline__ bool next(int i, Unit& u) const {
        const long U = (long)nT * nN; long L;
        if (nL > 0) { const int W = G - nL; const long early = (long)H * W;
            if (c >= nL) L = (i < H) ? (long)i * W + (c - nL) : early + (long)(i - H) * G + c;
            else L = early + (long)i * G + c; }
        else L = (long)i * G + c;
        if (L >= U) return false;
        const int l = (int)L, nig = WGM * nN, gid = l / nig, fm = gid * WGM, gsz = (nT - fm) < WGM ? (nT - fm) : WGM, rem = l % nig;
        const int tile = t0 + fm + rem % gsz, jn = rem / gsz;
        u.pm = tile; u.pn = texp[tile] * nN + jn; u.kt0 = 0; u.nkt = 0; u.split = 0; u.tq = 0; u.sl = 0; u.nsl = 1; return true;
    }
    __device__ __forceinline__ int arow(const Unit& u) const { return u.pm < 128 ? u.pm : u.pm + shift; }
};
struct LatCtxOrder {
    int G, c, mode, nN, nlat; TailSplit ts; StaticOrder so;
    __device__ __forceinline__ void init(int G_, int c_, int nt, int mode_ = 1, int nN_ = 4) { G = G_; c = c_; mode = mode_; nN = nN_; nlat = 128 * nN_; so.init(128 * BM, nN_ * BM, G_, c_); ts.init(16, G_, nt, 8); if (!TAIL_SPLIT) { ts.nsl = 1; ts.pairs_s = ts.pairs; } }
    __device__ __forceinline__ bool next(int i, Unit& u) const {
        const long L = (long)i * G + c;
        if (mode != 2 && L < nlat) { so.next(i, u); const int vm = u.pm; u.pm = (vm >> 5) * 33 + 1 + (vm & 31); return true; }
        if (mode == 0) return false;
        const long j = mode == 2 ? L : L - nlat; const int q = (int)(j / ts.nsl), sl = (int)(j % ts.nsl); if (q >= 4 * nN) return false;
        u.pm = (q / nN) * 33; u.pn = q % nN; u.kt0 = 0; u.nkt = 0; u.split = 0; u.tq = 0; u.sl = 0; u.nsl = 1; if (TAIL_SPLIT) ts.slice(sl, q, u); return true;
    }
    __device__ __forceinline__ int arow(const Unit& u) const { return u.pm; }
};

__device__ __forceinline__ unsigned cvt_pk_bf16(float lo, float hi) { unsigned r; asm volatile("v_cvt_pk_bf16_f32 %0, %1, %2" : "=v"(r) : "v"(lo), "v"(hi)); return r; }

template <class Epi, class Sched, bool ALIGN_EPI, bool GATHER>
__device__ __forceinline__ void gemm_phase(PG8_LAS unsigned char* lds, const Gemm g, const Sched& S, const Epi& E, const int* gidx) {
    int tid_ = threadIdx.x; asm volatile("" : "+v"(tid_));
    const int tid = tid_, wid = __builtin_amdgcn_readfirstlane(tid >> 6), lane = tid & 63, wr = wid >> 2, wc = wid & 3, fr = lane & 15, fq = lane >> 4;
    const int K = g.K, nt = K / BK;
    unsigned voffB[2]; int RA[2]; unsigned colA[2];
#pragma unroll
    for (int i = 0; i < 2; ++i) { int R, C; stage_rc(tid * 16 + i * 8192, R, C); const int Rb = Epi::PERM ? ((R & ~31) + perm32(R & 31)) : R;
        RA[i] = R; colA[i] = (unsigned)C * 2u; voffB[i] = (unsigned)(Rb * K + C) * 2u; }
    const size_t kstep = (size_t)(BK * 2);
    const size_t hstep = (size_t)HALF * K * 2;
    const size_t tstep = 2 * hstep;
    const unsigned ldsw = (unsigned)wid * 1024u;
    const int aoff = lds_byte(wr * 64 + fr, fq * 8), boff = lds_byte(wc * 32 + fr, fq * 8);
#define PG8_SA(b, h) (((b) * 2 + (h)) * HTB)
#define PG8_SB(b, h) ((4 + (b) * 2 + (h)) * HTB)
#define PG8_STAGE(bufoff, gbase, voff) do { _Pragma("unroll") for (int _i = 0; _i < 2; ++_i) \
        __builtin_amdgcn_global_load_lds((const unsigned*)((const char*)(gbase) + (voff)[_i]), (PG8_LAS unsigned*)(lds + (bufoff) + ldsw + _i * 8192), 16, 0, 0); } while (0)
#define PG8_STAGE_A(bufoff, gbase, o, h) do { _Pragma("unroll") for (int _i = 0; _i < 2; ++_i) \
        __builtin_amdgcn_global_load_lds((const unsigned*)((const char*)(gbase) + (o)[h][_i]), (PG8_LAS unsigned*)(lds + (bufoff) + ldsw + _i * 8192), 16, 0, 0); } while (0)
#define PG8_SETOFF(o, u) do { _Pragma("unroll") for (int _h = 0; _h < 2; ++_h) _Pragma("unroll") for (int _i = 0; _i < 2; ++_i) { \
        if constexpr (GATHER) { int _t = gidx[(u).pm * BM + _h * HALF + RA[_i]]; _t = _t < 0 ? 0 : _t; (o)[_h][_i] = (unsigned)_t * (unsigned)(K * 2) + colA[_i]; } \
        else { (o)[_h][_i] = (unsigned)(_h * HALF + RA[_i]) * (unsigned)(K * 2) + colA[_i]; } } } while (0)
#define PG8_LDA(dst, b, h) do { _Pragma("unroll") for (int m = 0; m < 4; ++m) _Pragma("unroll") for (int k = 0; k < 2; ++k) dst[m][k] = *(const PG8_LAS bf16x8*)(lds + PG8_SA(b, h) + aoff + m * 2048 + k * 1024); } while (0)
#define PG8_LDB(dst, b, h) do { _Pragma("unroll") for (int n = 0; n < 2; ++n) _Pragma("unroll") for (int k = 0; k < 2; ++k) dst[n][k] = *(const PG8_LAS bf16x8*)(lds + PG8_SB(b, h) + boff + n * 2048 + k * 1024); } while (0)
#define PG8_MMA(ai, bj, At, Bt) do { __builtin_amdgcn_s_setprio(1); _Pragma("unroll") for (int m = 0; m < 4; ++m) _Pragma("unroll") for (int n = 0; n < 2; ++n) _Pragma("unroll") for (int k = 0; k < 2; ++k) \
        acc[ai][bj][m][n] = __builtin_amdgcn_mfma_f32_16x16x32_bf16(Bt[n][k], At[m][k], acc[ai][bj][m][n], 0, 0, 0); __builtin_amdgcn_s_setprio(0); } while (0)
#define PG8_WAIT_V(n) asm volatile("s_waitcnt vmcnt(" #n ")" ::: "memory")
#define PG8_WAIT_L(n) asm volatile("s_waitcnt lgkmcnt(" #n ")" ::: "memory")
#define PG8_BAR __builtin_amdgcn_s_barrier()
#define PG8_SCHED __builtin_amdgcn_sched_barrier(0)
    Unit cur, nxt;
    int ui = 0;
    if (!S.next(0, cur)) return;
    f32x4 acc[2][2][4][2];
#pragma unroll
    for (int a = 0; a < 2; ++a)
#pragma unroll
        for (int b = 0; b < 2; ++b)
#pragma unroll
            for (int m = 0; m < 4; ++m)
#pragma unroll
                for (int n = 0; n < 2; ++n) acc[a][b][m][n] = (f32x4){0.f, 0.f, 0.f, 0.f};
    bf16x8 At[4][2], B0[2][2], B1[2][2];
    unsigned oc[2][2], on[2][2];
    PG8_SETOFF(oc, cur);
    if (cur.nkt == 0) cur.nkt = nt;
    const char* cA = (GATHER ? (const char*)g.A : (const char*)g.A + (size_t)S.arow(cur) * tstep) + (size_t)cur.kt0 * kstep; const char* cB = (const char*)g.Bt + (size_t)cur.pn * tstep + (size_t)cur.kt0 * kstep;
    PG8_STAGE(PG8_SB(0, 0), cB, voffB); PG8_STAGE(PG8_SB(0, 1), cB + hstep, voffB); PG8_STAGE_A(PG8_SA(0, 0), cA, oc, 0); PG8_STAGE_A(PG8_SA(0, 1), cA, oc, 1);
    if (wr == 1) PG8_BAR;
    PG8_WAIT_V(2); PG8_BAR;
    PG8_STAGE(PG8_SB(1, 0), cB + kstep, voffB); PG8_STAGE_A(PG8_SA(1, 0), cA + kstep, oc, 0); PG8_STAGE(PG8_SB(1, 1), cB + hstep + kstep, voffB);
    PG8_WAIT_V(6); PG8_BAR;
    for (;;) {
        const bool has_next = S.next(ui + 1, nxt);
        if (has_next) { if (nxt.nkt == 0) nxt.nkt = nt; PG8_SETOFF(on, nxt); } else {
#pragma unroll
            for (int h = 0; h < 2; ++h)
#pragma unroll
                for (int i = 0; i < 2; ++i) on[h][i] = oc[h][i]; }
        const char* nA = has_next ? (GATHER ? (const char*)g.A : (const char*)g.A + (size_t)S.arow(nxt) * tstep) + (size_t)nxt.kt0 * kstep : cA; const char* nB = has_next ? (const char*)g.Bt + (size_t)nxt.pn * tstep + (size_t)nxt.kt0 * kstep : cB;
        const int ntc = cur.nkt;
        for (int t = 0; t < ntc; t += 2) {
            const bool last = (t == ntc - 2);
            const char* a1 = cA + (size_t)(t + 1) * kstep;
            const char* a2 = last ? nA : cA + (size_t)(t + 2) * kstep; const char* b2 = last ? nB : cB + (size_t)(t + 2) * kstep;
            const char* a3 = a2 + kstep; const char* b3 = b2 + kstep;
            unsigned o2[2][2];
#pragma unroll
            for (int h = 0; h < 2; ++h)
#pragma unroll
                for (int i = 0; i < 2; ++i) o2[h][i] = last ? on[h][i] : oc[h][i];
            PG8_LDB(B0, 0, 0); PG8_LDB(B1, 0, 1); PG8_SCHED; PG8_LDA(At, 0, 0); PG8_STAGE_A(PG8_SA(1, 1), a1, oc, 1);
            PG8_WAIT_V(8); PG8_WAIT_L(0); PG8_BAR; PG8_MMA(0, 0, At, B0); PG8_MMA(0, 1, At, B1); PG8_BAR; PG8_SCHED;
            PG8_LDA(At, 0, 1); PG8_STAGE(PG8_SB(0, 0), b2, voffB); PG8_STAGE(PG8_SB(0, 1), b2 + hstep, voffB); PG8_STAGE_A(PG8_SA(0, 0), a2, o2, 0);
            PG8_WAIT_V(8); PG8_WAIT_L(0); PG8_BAR; PG8_MMA(1, 0, At, B0); PG8_MMA(1, 1, At, B1); PG8_BAR; PG8_SCHED;
            PG8_LDB(B0, 1, 0); PG8_LDB(B1, 1, 1); PG8_SCHED; PG8_LDA(At, 1, 0); PG8_STAGE_A(PG8_SA(0, 1), a2, o2, 1);
            PG8_WAIT_V(8); PG8_WAIT_L(0); PG8_BAR; PG8_MMA(0, 0, At, B0); PG8_MMA(0, 1, At, B1); PG8_BAR; PG8_SCHED;
            PG8_LDA(At, 1, 1); PG8_STAGE(PG8_SB(1, 0), b3, voffB); PG8_STAGE(PG8_SB(1, 1), b3 + hstep, voffB); PG8_STAGE_A(PG8_SA(1, 0), a3, o2, 0);
            PG8_WAIT_V(8); PG8_WAIT_L(0); PG8_BAR; PG8_MMA(1, 0, At, B0); PG8_MMA(1, 1, At, B1); PG8_BAR; PG8_SCHED;
        }
        if constexpr (ALIGN_EPI) { if (wr == 0) PG8_BAR; }
        E(acc, cur, wr, wc, fr, fq);
        if (!has_next) break;
#pragma unroll
        for (int a = 0; a < 2; ++a)
#pragma unroll
            for (int b = 0; b < 2; ++b)
#pragma unroll
                for (int m = 0; m < 4; ++m)
#pragma unroll
                    for (int n = 0; n < 2; ++n) acc[a][b][m][n] = (f32x4){0.f, 0.f, 0.f, 0.f};
        cur = nxt; cA = nA; cB = nB; ++ui;
#pragma unroll
        for (int h = 0; h < 2; ++h)
#pragma unroll
            for (int i = 0; i < 2; ++i) oc[h][i] = on[h][i];
        if constexpr (ALIGN_EPI) { if (wr == 1) PG8_BAR; }
    }
    PG8_WAIT_V(0);
    if constexpr (!ALIGN_EPI) { if (wr == 0) PG8_BAR; }
    PG8_BAR;
#undef PG8_SA
#undef PG8_SB
#undef PG8_STAGE
#undef PG8_STAGE_A
#undef PG8_SETOFF
#undef PG8_LDA
#undef PG8_LDB
#undef PG8_MMA
#undef PG8_WAIT_V
#undef PG8_WAIT_L
#undef PG8_BAR
#undef PG8_SCHED
}
}

constexpr int NWAVES = 8, NTHR = 512;
constexpr int NB = 4, SEQ = 8192, LCTX = 256, TT = SEQ + LCTX  , MROWS = NB * TT  , MLAT = NB * SEQ, DM = 1024;
constexpr int PPB = TT / 256;
constexpr int NCH = TT / 128;
constexpr int EVEN_IN = 5664, FFD = 2816, FFE = 3584, NEXP = 8;
constexpr int NA_TILES = 15;
constexpr int MOE_TILES = 136;
constexpr int MOE_HID_TILES = 144;
constexpr float NORM_EPS = 1e-6f;
constexpr float LAM_INIT = 0.35550906759096926f;
constexpr float LOG2E = 1.4426950408889634f;

constexpr size_t al256(size_t x) { return (x + 255) & ~(size_t)255; }
constexpr size_t WS_CTL = 0, CTL_BYTES = 1u << 20;
constexpr size_t WS_MOD = WS_CTL + CTL_BYTES;
constexpr size_t WS_SCAL = WS_MOD + al256(2 * 5 * 6144 * 4);
constexpr size_t WS_ROPER = WS_SCAL + 4096;
constexpr size_t WS_ROPEC = WS_ROPER + 128 * 16 * 8;
constexpr size_t WS_META = WS_ROPEC + 64 * 16 * 8;
constexpr size_t WS_ROPERET = WS_META + 4096;
constexpr size_t WS_WINA = WS_ROPERET + al256((size_t)TT * 64 * 8);
constexpr size_t WS_WINB = WS_WINA + (size_t)3840 * 1024 * 2;
constexpr size_t WS_WOUT0 = WS_WINB + (size_t)2048 * 1024 * 2;
constexpr size_t WS_WGU0 = WS_WOUT0 + (size_t)1024 * 2048 * 2;
constexpr size_t WS_WDN0 = WS_WGU0 + (size_t)5632 * 1024 * 2;
constexpr size_t WS_WQK = WS_WDN0 + (size_t)1024 * 2816 * 2;
constexpr size_t WS_WV = WS_WQK + (size_t)2048 * 1024 * 2;
constexpr size_t WS_WO1 = WS_WV + (size_t)1024 * 1024 * 2;
constexpr size_t WS_XC = WS_WO1 + (size_t)1024 * 1024 * 2;
constexpr size_t WS_DT = WS_XC + (size_t)1024 * 1024 * 4;
constexpr size_t WS_LA = WS_DT + (size_t)MROWS * 32 * 4;
constexpr size_t WS_TOKE = WS_LA + (size_t)MROWS * 32 * 4;
constexpr size_t WS_TOKR = WS_TOKE + (size_t)2 * MLAT * 4;
constexpr size_t WS_TOKW = WS_TOKR + (size_t)2 * MLAT * 4;
constexpr size_t WS_SLOTT = WS_TOKW + (size_t)2 * MLAT * 4;
constexpr size_t WS_SLOTW = WS_SLOTT + (size_t)2 * MOE_TILES * 256 * 4;
constexpr size_t WS_H = al256(WS_SLOTW + (size_t)2 * MOE_TILES * 256 * 4);
constexpr size_t WS_R = WS_H + (size_t)MROWS * 1024 * 2;
constexpr size_t MiB = 1u << 20;
constexpr size_t R_XS = WS_R, R_RV = WS_R + 66 * MiB, R_Y = WS_R + 132 * MiB, R_BCRAW = R_Y, R_RK = R_Y + 33 * MiB;
constexpr size_t R_S = WS_R + 264 * MiB, R_KT = R_S + (size_t)NB * NCH * 6 * 32768, R_CMC = R_KT + (size_t)NB * NCH * 6 * 32768, R_RQ = R_CMC + (size_t)MROWS * 256 * 2;
constexpr size_t R_DEC = R_RQ + 33 * MiB;
constexpr int DEC_STRIDE = 784;
constexpr size_t R_Z = R_S, R_RG = R_S + 66 * MiB;
constexpr size_t R_ZC = WS_R + 426 * MiB, R_RGC = R_ZC + 2 * MiB;
constexpr size_t R_HID = WS_R;
constexpr size_t R_PART0 = WS_R + 264 * MiB;
constexpr size_t R_PART1 = WS_R + 239 * MiB;
constexpr size_t R_MOESCR = WS_R + 252 * MiB;
static_assert(R_RG + 66 * MiB <= R_RQ + 33 * MiB, "gate buffers alias dead scan buffers");
constexpr size_t R_Q = WS_R, R_K = WS_R + 66 * MiB, R_VT = WS_R + 132 * MiB, R_O = WS_R + 198 * MiB;
constexpr size_t R_MOEGU = WS_R + 264 * MiB, R_MOEDN = R_MOEGU + (size_t)NEXP * 7168 * 1024 * 2;
constexpr size_t R_HID2 = WS_R;
constexpr size_t WS_END = R_MOEDN + (size_t)NEXP * 1024 * FFE * 2;
static_assert((size_t)MOE_HID_TILES * 256 * FFE * 2 <= 264 * MiB && (size_t)MOE_TILES * 256 * FFE * 2 <= 239 * MiB && R_PART1 + (size_t)96 * 262144 <= R_MOEGU && (size_t)MOE_TILES * 256 * FFE * 2 <= 264 * MiB && R_DEC + (size_t)NB * NCH * 16 * DEC_STRIDE * 4 <= R_ZC && R_RGC + 2 * MiB <= WS_END, "map");
constexpr int CW_TMO = 0, CW_BAR = 4096, CW_CNT = 8192, CW_TKT = 16384;

#define GAS __attribute__((address_space(1)))
#define LAS __attribute__((address_space(3)))
typedef unsigned short bf16;
typedef unsigned v4u __attribute__((ext_vector_type(4)));
typedef unsigned v2u __attribute__((ext_vector_type(2)));
typedef float f32x4 __attribute__((ext_vector_type(4)));
typedef float f32x2 __attribute__((ext_vector_type(2)));
typedef float f32x16 __attribute__((ext_vector_type(16)));
typedef short bf16x8 __attribute__((ext_vector_type(8)));
#define RLX_AGENT __ATOMIC_RELAXED, __HIP_MEMORY_SCOPE_AGENT
__device__ __forceinline__ unsigned f2bf(float f) { unsigned u = __builtin_bit_cast(unsigned, f); return (u + 0x7fffu + ((u >> 16) & 1u)) >> 16; }
__device__ __forceinline__ unsigned pk2(float lo, float hi) { return pg8::cvt_pk_bf16(lo, hi); }
__device__ __forceinline__ float bf2f(unsigned short b) { return __builtin_bit_cast(float, (unsigned)b << 16); }
__device__ __forceinline__ float bflo(unsigned w) { return __builtin_bit_cast(float, w << 16); }
__device__ __forceinline__ float bfhi(unsigned w) { return __builtin_bit_cast(float, w & 0xffff0000u); }
__device__ __forceinline__ float fast_rcp(float x) { return __builtin_amdgcn_rcpf(x); }
__device__ __forceinline__ float fast_exp2(float x) { return __builtin_amdgcn_exp2f(x); }
__device__ __forceinline__ float silu_f(float x) { return x * fast_rcp(1.0f + fast_exp2(-LOG2E * x)); }
__device__ __forceinline__ float wave_sum(float v) {
#pragma unroll
    for (int o = 1; o < 64; o <<= 1) v += __shfl_xor(v, o);
    return v;
}

#define XB_TMO      128
#define XB_XCNT(j)  (256  + 64 * (j))
#define XB_XSUB(j)  (1280 + 64 * (j))
#define XB_XGEN(j)  (2304 + 64 * (j))
#define XB_TOP      3328
#define XB_TOPGEN   3392
#define XCD_BAR_WORDS 3456
#define XB_SPIN_CAP (1u << 18)
__device__ __forceinline__ unsigned xb_ld(unsigned* p)              { return __hip_atomic_load(p, __ATOMIC_RELAXED, __HIP_MEMORY_SCOPE_AGENT); }
__device__ __forceinline__ unsigned xb_add(unsigned* p, unsigned v) { return __hip_atomic_fetch_add(p, v, __ATOMIC_RELAXED, __HIP_MEMORY_SCOPE_AGENT); }
__device__ __forceinline__ unsigned xb_xcc_id() { return (unsigned)__builtin_amdgcn_s_getreg((3 << 11) | 20) & 0xFu; }
#define XB_SPIN(cond, bar) do { unsigned _sp = 0; while (cond) { __builtin_amdgcn_s_sleep(1); \
    if ((++_sp & 255u) == 0u) { if (xb_ld(&(bar)[XB_TMO])) break; if (_sp > XB_SPIN_CAP) { atomicAdd(&(bar)[XB_TMO], 1u); break; } } } } while (0)
struct XcdBarrier { unsigned* bar; unsigned x; volatile LAS unsigned* st; };
__device__ __forceinline__ XcdBarrier xcd_barrier_post(unsigned* bar, volatile LAS unsigned* st) {
    XcdBarrier b; b.bar = bar; b.x = xb_xcc_id(); b.st = st;
    if (threadIdx.x == 0) (void)xb_add(&bar[XB_XCNT(b.x)], 1u);
    return b;
}
__device__ __forceinline__ void xcd_barrier_complete(unsigned* bar, unsigned x, unsigned& nloc, unsigned& nx) {
    const unsigned G = gridDim.x * gridDim.y * gridDim.z;
    unsigned sum, cnt, mine, sp = 0u;
    for (;;) {
        sum = 0u; cnt = 0u; mine = 0u;
#pragma unroll
        for (unsigned j = 0; j < 16; ++j) { const unsigned c = xb_ld(&bar[XB_XCNT(j)]); sum += c; cnt += (c > 0u) ? 1u : 0u; mine = (j == x) ? c : mine; }
        if (sum == G) break;
        __builtin_amdgcn_s_sleep(1);
        if ((++sp & 255u) == 0u) { if (xb_ld(&bar[XB_TMO])) break; if (sp > XB_SPIN_CAP) { atomicAdd(&bar[XB_TMO], 1u); break; } }
    }
    nloc = mine > 0u ? mine : 1u; nx = cnt > 0u ? cnt : 1u;
}
__device__ __forceinline__ void xcd_barrier(const XcdBarrier& b) {
    asm volatile("s_waitcnt vmcnt(0)" ::: "memory");
    __syncthreads();
    if (threadIdx.x == 0) {
        unsigned* bar = b.bar;
        __builtin_amdgcn_s_waitcnt(0);
        unsigned nloc = b.st[0], nx = b.st[1];
        if (nloc == 0u) { xcd_barrier_complete(bar, b.x, nloc, nx); b.st[0] = nloc; b.st[1] = nx; }
        const unsigned old = xb_add(&bar[XB_XSUB(b.x)], 1u);
        const unsigned gen = old / nloc;
        if (old + 1u == (gen + 1u) * nloc) {
            __builtin_amdgcn_fence(__ATOMIC_RELEASE, "agent");
            asm volatile("s_waitcnt vmcnt(0)" ::: "memory");
            const unsigned og = xb_add(&bar[XB_TOP], 1u);
            const unsigned tg = og / nx;
            if (og + 1u == (tg + 1u) * nx) xb_add(&bar[XB_TOPGEN], 1u);
            else XB_SPIN(xb_ld(&bar[XB_TOPGEN]) == tg, bar);
            __builtin_amdgcn_fence(__ATOMIC_ACQUIRE, "agent");
            xb_add(&bar[XB_XGEN(b.x)], 1u);
            asm volatile("s_waitcnt vmcnt(0)" ::: "memory");
        } else {
            XB_SPIN(xb_ld(&bar[XB_XGEN(b.x)]) == gen, bar);
            __builtin_amdgcn_fence(__ATOMIC_ACQUIRE, "agent");
            asm volatile("s_waitcnt vmcnt(0)" ::: "memory");
        }
    }
    __syncthreads();
}

using pg8::Unit;
struct EpiStore {
    static constexpr bool PERM = true;
    bf16* O0; bf16* O1; int tiles0, ld0, ld1; int rdiv = 0;
    __device__ __forceinline__ void operator()(f32x4 (&acc)[2][2][4][2], const Unit& u, int wr, int wc, int fr, int fq) const {
        const bool first = u.pn < tiles0; bf16* base = first ? O0 : O1; const int ld = first ? ld0 : ld1; const int ct = first ? u.pn : u.pn - tiles0;
        const int row0 = (rdiv > 1 ? u.pm / rdiv : u.pm) * 256 + wr * 64 + fr, col0 = ct * 256 + wc * 32 + 8 * fq;
#pragma unroll
        for (int ai = 0; ai < 2; ++ai)
#pragma unroll
            for (int m = 0; m < 4; ++m) { bf16* rowp = base + (size_t)(row0 + ai * 128 + m * 16) * ld + col0;
#pragma unroll
                for (int bj = 0; bj < 2; ++bj) { const f32x4 v0 = acc[ai][bj][m][0], v1 = acc[ai][bj][m][1]; v4u w;
                    w.x = pk2(v0[0], v0[1]); w.y = pk2(v0[2], v0[3]); w.z = pk2(v1[0], v1[1]); w.w = pk2(v1[2], v1[3]);
                    *(v4u*)(rowp + bj * 128) = w; } }
    }
};
__device__ __forceinline__ float softplus_f(float x) { const float ex = __expf(x); return x > 20.f ? x : (ex < 0.01f ? ex * (1.0f - ex * (0.5f - ex * 0.33333334f)) : __logf(1.0f + ex)); }
__device__ __forceinline__ void store_tile(const f32x4 (&acc)[2][2][4][2], bf16* base, int ld, int ct, int row0, int wc, int fq) {
    const int col0 = ct * 256 + wc * 32 + 8 * fq;
#pragma unroll
    for (int ai = 0; ai < 2; ++ai)
#pragma unroll
        for (int m = 0; m < 4; ++m) { bf16* rowp = base + (size_t)(row0 + ai * 128 + m * 16) * ld + col0;
#pragma unroll
            for (int bj = 0; bj < 2; ++bj) { const f32x4 v0 = acc[ai][bj][m][0], v1 = acc[ai][bj][m][1]; v4u w;
                w.x = pk2(v0[0], v0[1]); w.y = pk2(v0[2], v0[3]); w.z = pk2(v1[0], v1[1]); w.w = pk2(v1[2], v1[3]);
                *(v4u*)(rowp + bj * 128) = w; } }
}
struct EpiInA {
    static constexpr bool PERM = true;
    bf16 *XS, *BCRAW, *RQ, *RK, *RV; float *DT, *LA; const float* rope; const float* dt_bias; const float* a_log;
    __device__ __forceinline__ void operator()(f32x4 (&acc)[2][2][4][2], const Unit& u, int wr, int wc, int fr, int fq) const {
        const int t = u.pn, row0 = u.pm * 256 + wr * 64 + fr;
        if (t < 4) store_tile(acc, XS, 1024, t, row0, wc, fq);
        else if (t < 6) store_tile(acc, BCRAW, 512, t - 4, row0, wc, fq);
        else if (t >= 10 && t < 14) store_tile(acc, RV, 1024, t - 10, row0, wc, fq);
        else if (t < 10) {
            const bool isk = t >= 8; bf16* base = isk ? RK : RQ; const int hp = (isk ? t - 8 : t - 6) * 2;
            const int q = wc * 32 + 8 * fq, head = hp + (q >> 6), d0 = q & 63; const float sc = isk ? 0.08838834764831845f : 1.0f;
#pragma unroll
            for (int ai = 0; ai < 2; ++ai)
#pragma unroll
                for (int m = 0; m < 4; ++m) { const int row = row0 + ai * 128 + m * 16; const int pos = row % TT;
                    const f32x4* rp = (const f32x4*)(rope + ((size_t)pos * 64 + d0) * 2);
                    const f32x4 c0 = rp[0], c1 = rp[1], c2 = rp[2], c3 = rp[3];
                    const f32x4 a0 = acc[ai][0][m][0], a1 = acc[ai][0][m][1], b0 = acc[ai][1][m][0], b1 = acc[ai][1][m][1];
                    const f32x4 cs0 = {c0[0], c0[2], c1[0], c1[2]}, sn0 = {c0[1], c0[3], c1[1], c1[3]}, cs1 = {c2[0], c2[2], c3[0], c3[2]}, sn1 = {c2[1], c2[3], c3[1], c3[3]};
                    const f32x4 p0 = (a0 * cs0 - b0 * sn0) * sc, p1 = (a1 * cs1 - b1 * sn1) * sc, q0 = (a0 * sn0 + b0 * cs0) * sc, q1 = (a1 * sn1 + b1 * cs1) * sc;
                    bf16* rowp = base + (size_t)row * 512 + head * 128 + d0; v4u w;
                    w.x = pk2(p0[0], p0[1]); w.y = pk2(p0[2], p0[3]); w.z = pk2(p1[0], p1[1]); w.w = pk2(p1[2], p1[3]); *(v4u*)rowp = w;
                    w.x = pk2(q0[0], q0[1]); w.y = pk2(q0[2], q0[3]); w.z = pk2(q1[0], q1[1]); w.w = pk2(q1[2], q1[3]); *(v4u*)(rowp + 64) = w; }
        } else {
            if (wc == 0) {
                const int c0 = 8 * fq;
                const f32x4 bi0 = *(const f32x4*)(dt_bias + c0), bi1 = *(const f32x4*)(dt_bias + c0 + 4), al0 = *(const f32x4*)(a_log + c0), al1 = *(const f32x4*)(a_log + c0 + 4);
                f32x4 ae0, ae1;
#pragma unroll
                for (int j = 0; j < 4; ++j) { ae0[j] = -__expf(al0[j]); ae1[j] = -__expf(al1[j]); }
#pragma unroll
                for (int ai = 0; ai < 2; ++ai)
#pragma unroll
                    for (int m = 0; m < 4; ++m) { const int row = row0 + ai * 128 + m * 16; const f32x4 x0 = acc[ai][0][m][0] + bi0, x1 = acc[ai][0][m][1] + bi1; f32x4 d0v, d1v;
#pragma unroll
                        for (int j = 0; j < 4; ++j) { d0v[j] = softplus_f(x0[j]); d1v[j] = softplus_f(x1[j]); }
                        f32x4* pd = (f32x4*)(DT + (size_t)row * 32 + c0); f32x4* pl = (f32x4*)(LA + (size_t)row * 32 + c0);
                        pd[0] = d0v; pd[1] = d1v; pl[0] = d0v * ae0; pl[1] = d1v * ae1; }
            }
        }
    }
};
struct TailMeet { float* part; unsigned* tkt; volatile LAS unsigned* flag; };
__device__ __forceinline__ bool tail_meet(const TailMeet& tm, f32x4 (&acc)[2][2][4][2], const Unit& u) {
    const int tid = threadIdx.x;
    float* mine = tm.part + ((size_t)u.tq * u.nsl + u.sl) * 65536 + (size_t)tid * 4;
#pragma unroll
    for (int ai = 0; ai < 2; ++ai)
#pragma unroll
        for (int bj = 0; bj < 2; ++bj)
#pragma unroll
            for (int m = 0; m < 4; ++m)
#pragma unroll
                for (int n = 0; n < 2; ++n) { float* q = mine + (size_t)(((ai * 2 + bj) * 4 + m) * 2 + n) * 2048; const f32x4 v = acc[ai][bj][m][n];
                    asm volatile("global_store_dwordx4 %0, %1, off sc1" :: "v"(q), "v"(v) : "memory"); }
    asm volatile("s_waitcnt vmcnt(0)" ::: "memory");
    __syncthreads();
    if (tid == 0) tm.flag[0] = __hip_atomic_fetch_add(tm.tkt + 64 * u.tq, 1u, __ATOMIC_RELAXED, __HIP_MEMORY_SCOPE_AGENT);
    __syncthreads();
    const unsigned t = tm.flag[0];
    if (t != (unsigned)(u.nsl - 1)) return false;
    __builtin_amdgcn_fence(__ATOMIC_ACQUIRE, "agent");
    asm volatile("s_waitcnt vmcnt(0)" ::: "memory");
#pragma unroll
    for (int ai = 0; ai < 2; ++ai)
#pragma unroll
        for (int bj = 0; bj < 2; ++bj)
#pragma unroll
            for (int m = 0; m < 4; ++m)
#pragma unroll
                for (int n = 0; n < 2; ++n) acc[ai][bj][m][n] = (f32x4){0.f, 0.f, 0.f, 0.f};
    for (int s = 0; s < u.nsl; ++s) { const float* src = tm.part + ((size_t)u.tq * u.nsl + s) * 65536 + (size_t)tid * 4;
#pragma unroll
        for (int ai = 0; ai < 2; ++ai)
#pragma unroll
            for (int bj = 0; bj < 2; ++bj)
#pragma unroll
                for (int m = 0; m < 4; ++m)
#pragma unroll
                    for (int n = 0; n < 2; ++n) acc[ai][bj][m][n] += *(const f32x4*)(src + (size_t)(((ai * 2 + bj) * 4 + m) * 2 + n) * 2048); }
    return true;
}
template <bool COMB> struct EpiRes {
    static constexpr bool PERM = false;
    const float* base_lat; const float* base_ctx; float* out_lat; float* out_ctx; const float* gate; TailMeet tm;
    __device__ __forceinline__ void operator()(f32x4 (&acc)[2][2][4][2], const Unit& u, int wr, int wc, int fr, int fq) const {
        const float* bp; float* op; const float* gp;
        if (COMB) { const int b = u.pm / PPB, pt = u.pm % PPB;
            if (pt == 0) { bp = base_ctx + (size_t)b * 256 * DM; op = out_ctx + (size_t)b * 256 * DM; gp = gate + 4 * 6144; }
            else { const size_t r = (size_t)b * SEQ + (size_t)(pt - 1) * 256; bp = base_lat + r * DM; op = out_lat + r * DM; gp = gate + b * 6144; }
        } else { const int b = u.pm / 32; bp = base_lat + (size_t)u.pm * 256 * DM; op = out_lat + (size_t)u.pm * 256 * DM; gp = gate + b * 6144; }
        const int col0 = u.pn * 256 + wc * 32 + 4 * fq;
        f32x4 gv[2][2];
#pragma unroll
        for (int bj = 0; bj < 2; ++bj)
#pragma unroll
            for (int n = 0; n < 2; ++n) gv[bj][n] = *(const f32x4*)(gp + col0 + bj * 128 + n * 16);
        if (u.split) { if (!tail_meet(tm, acc, u)) return; }
#pragma unroll
        for (int ai = 0; ai < 2; ++ai)
#pragma unroll
            for (int m = 0; m < 4; ++m) { const size_t off = (size_t)(ai * 128 + wr * 64 + m * 16 + fr) * DM + col0;
#pragma unroll
                for (int bj = 0; bj < 2; ++bj)
#pragma unroll
                    for (int n = 0; n < 2; ++n) { const f32x4 bs = *(const f32x4*)(bp + off + bj * 128 + n * 16);
                        *(f32x4*)(op + off + bj * 128 + n * 16) = bs + gv[bj][n] * acc[ai][bj][m][n]; } }
    }
};
struct EpiSwiglu {
    static constexpr bool PERM = true;
    bf16* O; int ldc; int nN; int rshift;
    __device__ __forceinline__ void operator()(f32x4 (&acc)[2][2][4][2], const Unit& u, int wr, int wc, int fr, int fq) const {
        const int ct = nN ? u.pn % nN : u.pn; const int rt = u.pm < 128 ? u.pm : u.pm + rshift; const int row0 = rt * 256 + wr * 64 + fr, col0 = ct * 128 + wc * 32 + 8 * fq;
#pragma unroll
        for (int ai = 0; ai < 2; ++ai)
#pragma unroll
            for (int m = 0; m < 4; ++m) { const f32x4 g0 = acc[ai][0][m][0], g1 = acc[ai][0][m][1], u0 = acc[ai][1][m][0], u1 = acc[ai][1][m][1]; v4u w;
                w.x = pk2(silu_f(g0[0]) * u0[0], silu_f(g0[1]) * u0[1]); w.y = pk2(silu_f(g0[2]) * u0[2], silu_f(g0[3]) * u0[3]);
                w.z = pk2(silu_f(g1[0]) * u1[0], silu_f(g1[1]) * u1[1]); w.w = pk2(silu_f(g1[2]) * u1[2], silu_f(g1[3]) * u1[3]);
                *(v4u*)(O + (size_t)(row0 + ai * 128 + m * 16) * ldc + col0) = w; }
    }
};
struct EpiQK {
    static constexpr bool PERM = false;
    bf16 *Q, *K; const float *qg, *kg; const float *ropeR, *ropeC;
    __device__ __forceinline__ void operator()(f32x4 (&acc)[2][2][4][2], const Unit& u, int wr, int wc, int fr, int fq) const {
        const bool isk = u.pn >= 4; const int sub = (u.pn & 3) * 4 + wc; bf16* base = isk ? K : Q; const float* gn = isk ? kg : qg;
        const float osc = isk ? 1.0f : 0.125f * LOG2E;
        f32x4 g[2][2];
#pragma unroll
        for (int bj = 0; bj < 2; ++bj)
#pragma unroll
            for (int n = 0; n < 2; ++n) g[bj][n] = *(const f32x4*)(gn + 32 * bj + 16 * n + 4 * fq);
#pragma unroll
        for (int ai = 0; ai < 2; ++ai)
#pragma unroll
            for (int m = 0; m < 4; ++m) { const int row = u.pm * 256 + ai * 128 + wr * 64 + m * 16 + fr; const int t = row % TT;
                float ss = 0.f;
#pragma unroll
                for (int bj = 0; bj < 2; ++bj)
#pragma unroll
                    for (int n = 0; n < 2; ++n) { const f32x4 x = acc[ai][bj][m][n]; ss += (x[0] * x[0] + x[1] * x[1]) + (x[2] * x[2] + x[3] * x[3]); }
                ss += __shfl_xor(ss, 16); ss += __shfl_xor(ss, 32);
                const float rstd = __builtin_amdgcn_rsqf(ss * (1.0f / 64.0f) + NORM_EPS) ;
                f32x4 y[2][2];
#pragma unroll
                for (int bj = 0; bj < 2; ++bj)
#pragma unroll
                    for (int n = 0; n < 2; ++n) y[bj][n] = acc[ai][bj][m][n] * rstd * g[bj][n];
                if (t >= LCTX) { const int l = t - LCTX, gr = l >> 6, gc = l & 63;
                    const f32x4* pr = (const f32x4*)(ropeR + ((size_t)gr * 16 + 4 * fq) * 2); const f32x4* pc = (const f32x4*)(ropeC + ((size_t)gc * 16 + 4 * fq) * 2);
                    const f32x4 r0 = pr[0], r1 = pr[1], c0 = pc[0], c1 = pc[1];
                    const f32x4 csr = {r0[0], r0[2], r1[0], r1[2]}, snr = {r0[1], r0[3], r1[1], r1[3]}, csc = {c0[0], c0[2], c1[0], c1[2]}, snc = {c0[1], c0[3], c1[1], c1[3]};
                    const f32x4 a = y[0][0], b = y[0][1]; y[0][0] = a * csr - b * snr; y[0][1] = a * snr + b * csr;
                    const f32x4 c = y[1][0], d = y[1][1]; y[1][0] = c * csc - d * snc; y[1][1] = c * snc + d * csc; }
                if (isk || t >= LCTX) { bf16* rowp = base + (size_t)row * 1024 + sub * 64 + 4 * fq;
#pragma unroll
                    for (int bj = 0; bj < 2; ++bj)
#pragma unroll
                        for (int n = 0; n < 2; ++n) { const f32x4 o = y[bj][n] * osc; v2u w; w.x = pk2(o[0], o[1]); w.y = pk2(o[2], o[3]); *(v2u*)(rowp + 32 * bj + 16 * n) = w; } } }
    }
};
struct EpiMoeDownScratch {
    static constexpr bool PERM = false;
    float* scr; const float* gate; const int* slot_tok; const float* slot_w;
    __device__ __forceinline__ void operator()(f32x4 (&acc)[2][2][4][2], const Unit& u, int wr, int wc, int fr, int fq) const {
        const int col0 = (u.pn & 3) * 256 + wc * 32 + 4 * fq;
#pragma unroll
        for (int ai = 0; ai < 2; ++ai)
#pragma unroll
            for (int m = 0; m < 4; ++m) { const int slot = u.pm * 256 + ai * 128 + wr * 64 + m * 16 + fr; const int tok = slot_tok[slot];
                if (tok >= 0) { const float w = slot_w[slot]; const float* gp = gate + (tok >> 13) * 6144 + col0; float* op = scr + (size_t)(slot - 128 * 256) * DM + col0;
#pragma unroll
                    for (int bj = 0; bj < 2; ++bj)
#pragma unroll
                        for (int n = 0; n < 2; ++n) { const f32x4 gv = *(const f32x4*)(gp + bj * 128 + n * 16); *(f32x4*)(op + bj * 128 + n * 16) = gv * w * acc[ai][bj][m][n]; } } }
    }
};
struct EpiMoeDown {
    static constexpr bool PERM = false;
    float* out; const float* gate; const int* slot_tok; const float* slot_w; TailMeet tm;
    __device__ __forceinline__ void operator()(f32x4 (&acc)[2][2][4][2], const Unit& u, int wr, int wc, int fr, int fq) const {
        if (u.split) { if (!tail_meet(tm, acc, u)) return; }
        const int col0 = (u.pn & 3) * 256 + wc * 32 + 4 * fq;
#pragma unroll
        for (int ai = 0; ai < 2; ++ai)
#pragma unroll
            for (int m = 0; m < 4; ++m) { const int slot = u.pm * 256 + ai * 128 + wr * 64 + m * 16 + fr; const int tok = slot_tok[slot];
                if (tok >= 0) { const float w = slot_w[slot]; const float* gp = gate + (tok >> 13) * 6144 + col0; float* op = out + (size_t)tok * DM + col0;
#pragma unroll
                    for (int bj = 0; bj < 2; ++bj)
#pragma unroll
                        for (int n = 0; n < 2; ++n) { const f32x4 gv = *(const f32x4*)(gp + bj * 128 + n * 16); const f32x4 bs = *(const f32x4*)(op + bj * 128 + n * 16);
                            *(f32x4*)(op + bj * 128 + n * 16) = bs + gv * w * acc[ai][bj][m][n]; } } }
    }
};

enum InIdx { I_X = 0, I_C, I_CTX, I_CCTX, I_EWMOD, I_EBMOD, I_ENORM1, I_ENORM2, I_EWIN, I_ECONVW, I_ECONVB, I_EDTB, I_EALOG, I_ED, I_ESSDN, I_ERETD, I_EWOUT,
             I_EFG, I_EFU, I_EFD, I_OWMOD, I_OBMOD, I_ONORM1, I_ONORM2, I_OWIN, I_OQN, I_OKN, I_OLAM, I_OSUBLN, I_OWOUT, I_OROUTER, I_OEG, I_OEU, I_OED, N_IN };
#if defined(__HIP_DEVICE_COMPILE__)
#define ARG_AS GAS
#else
#define ARG_AS
#endif
struct Args { const ARG_AS float* in[N_IN]; ARG_AS float* out; ARG_AS unsigned char* ws; int ph_lo, ph_hi, zgate, pad; };
__device__ __forceinline__ ARG_AS unsigned char* launder_ptr(ARG_AS unsigned char* p) { asm volatile("" : "+s"(p)); return p; }

__device__ __forceinline__ unsigned pkc(float lo, float hi) {
    typedef __bf16 bf16x2_t __attribute__((ext_vector_type(2)));
    f32x2 v = {lo, hi}; bf16x2_t b = __builtin_convertvector(v, bf16x2_t); return __builtin_bit_cast(unsigned, b);
}
#define MFMA16(a, b, c) __builtin_amdgcn_mfma_f32_16x16x32_bf16(__builtin_bit_cast(bf16x8, a), __builtin_bit_cast(bf16x8, b), c, 0, 0, 0)
#define MFMA32(a, b, c) __builtin_amdgcn_mfma_f32_32x32x16_bf16(__builtin_bit_cast(bf16x8, a), __builtin_bit_cast(bf16x8, b), c, 0, 0, 0)

__device__ __forceinline__ void transpose_item(const float* W, int ldw, int col0, int k0, bf16* dst, size_t drow0, int K, LAS float* scr, int lane) {
    float t[32];
#pragma unroll
    for (int i = 0; i < 32; ++i) { const int kk = 2 * i + (lane >> 5); t[i] = W[(size_t)(k0 + kk) * ldw + col0 + (lane & 31)]; }
#pragma unroll
    for (int i = 0; i < 32; ++i) { const int kk = 2 * i + (lane >> 5); scr[kk * 33 + (lane & 31)] = t[i]; }
    asm volatile("s_waitcnt lgkmcnt(0)" ::: "memory");
    const int c = lane & 7;
#pragma unroll
    for (int j = 0; j < 4; ++j) { const int n = (lane >> 3) + 8 * j; const LAS float* s = scr + (8 * c) * 33 + n;
        v4u o; o.x = pk2(s[0 * 33], s[1 * 33]); o.y = pk2(s[2 * 33], s[3 * 33]); o.z = pk2(s[4 * 33], s[5 * 33]); o.w = pk2(s[6 * 33], s[7 * 33]);
        *(v4u*)(dst + (drow0 + n) * K + k0 + 8 * c) = o; }
    asm volatile("s_waitcnt lgkmcnt(0)" ::: "memory");
}
struct WJob { int nrg, nkb; };
__device__ __forceinline__ void small_weight_item(const Args& a, int mat, int rg, int kb, LAS float* scr, int lane) {
    unsigned char* ws = launder_ptr(a.ws); const int row = rg * 32;
    switch (mat) {
    case 0: { const float* W = a.in[I_EWIN]; int col; if (row < 1536) col = 1024 + row;
              else if (row < 2560) { const bool isk = row >= 2048; const int rr = row - (isk ? 2048 : 1536), tq = rr >> 8, p = rr & 255, half = p >> 7, q = p & 127; col = (isk ? 3104 : 2592) + (2 * tq + (q >> 6)) * 128 + (q & 63) + 64 * half; }
              else if (row < 3584) col = 3616 + (row - 2560); else col = 2560 + (row - 3584);
              transpose_item(W, EVEN_IN, col, kb * 64, (bf16*)(ws + WS_WINA), row, 1024, scr, lane); } break;
    case 1: { const int col = row < 1024 ? row : 4640 + (row - 1024); transpose_item(a.in[I_EWIN], EVEN_IN, col, kb * 64, (bf16*)(ws + WS_WINB), row, 1024, scr, lane); } break;
    case 2: transpose_item(a.in[I_EWOUT], 1024, row, kb * 64, (bf16*)(ws + WS_WOUT0), row, 2048, scr, lane); break;
    case 3: { const int tile = row >> 8, p = row & 255; const float* W = p < 128 ? a.in[I_EFG] : a.in[I_EFU]; transpose_item(W, FFD, tile * 128 + (p & 127), kb * 64, (bf16*)(ws + WS_WGU0), row, 1024, scr, lane); } break;
    case 4: transpose_item(a.in[I_EFD], 1024, row, kb * 64, (bf16*)(ws + WS_WDN0), row, FFD, scr, lane); break;
    case 5: { const int tile = row >> 8, p = row & 255, bj = p >> 7, wc = (p >> 5) & 3; const int col = (tile >= 4 ? 1024 : 0) + ((tile & 3) * 4 + wc) * 64 + 32 * bj;
              transpose_item(a.in[I_OWIN], 3072, col, kb * 64, (bf16*)(ws + WS_WQK), row, 1024, scr, lane); } break;
    case 6: transpose_item(a.in[I_OWIN], 3072, 2048 + row, kb * 64, (bf16*)(ws + WS_WV), row, 1024, scr, lane); break;
    default: transpose_item(a.in[I_OWOUT], 1024, row, kb * 64, (bf16*)(ws + WS_WO1), row, 1024, scr, lane); break;
    }
}
__device__ __forceinline__ void p0_prologue(const Args& a, LAS unsigned char* lds, int tid, int lane, int wave) {
    unsigned char* ws = launder_ptr(a.ws);
    const int G = gridDim.x, gw = blockIdx.x * NWAVES + wave, NGW = G * NWAVES;
    {
        LAS float* sc = (LAS float*)(lds + 131072 - 20480 - 10240);
        LAS float* red = (LAS float*)(lds + 131072 - 10240);
        for (int i = tid; i < 5 * 1024; i += NTHR) { const float v = i < 4096 ? a.in[I_C][i] : a.in[I_CCTX][i - 4096]; sc[i] = silu_f(v); }
        __syncthreads();
        for (int it = blockIdx.x; it < 2 * 96; it += G) {
            const int layer = it / 96, col0 = (it % 96) * 64; const float* W = layer ? a.in[I_OWMOD] : a.in[I_EWMOD]; const float* bm = layer ? a.in[I_OBMOD] : a.in[I_EBMOD];
            float acc[5] = {0.f, 0.f, 0.f, 0.f, 0.f};
#pragma unroll 8
            for (int k = wave * 128; k < wave * 128 + 128; ++k) { const float wv = W[(size_t)k * 6144 + col0 + lane];
#pragma unroll
                for (int c = 0; c < 5; ++c) acc[c] += sc[c * 1024 + k] * wv; }
#pragma unroll
            for (int c = 0; c < 5; ++c) red[(wave * 5 + c) * 64 + lane] = acc[c];
            __syncthreads();
            if (tid < 320) { const int c = tid >> 6, col = tid & 63; float s = bm[col0 + col];
#pragma unroll
                for (int w = 0; w < 8; ++w) s += red[(w * 5 + c) * 64 + col];
                ((float*)(ws + WS_MOD))[(size_t)(layer * 5 + c) * 6144 + col0 + col] = s; }
            __syncthreads();
        }
    }
    {
        LAS float* scr = (LAS float*)(lds + wave * 8704);
        const int nrg[8] = {113, 64, 32, 176, 32, 64, 32, 32}, nkb[8] = {16, 16, 32, 16, 44, 16, 16, 16};
        int total = 0;
#pragma unroll
        for (int m = 0; m < 8; ++m) total += nrg[m] * nkb[m];
        for (int it = gw; it < total; it += NGW) { int r = it, m = 0;
#pragma unroll
            for (int q = 0; q < 7; ++q) { if (m == q && r >= nrg[q] * nkb[q]) { r -= nrg[q] * nkb[q]; m = q + 1; } }
            int nk = 16; if (m == 2) nk = 32; else if (m == 4) nk = 44;
            small_weight_item(a, m, r / nk, r % nk, scr, lane); }
    }
    {
        const int gt = blockIdx.x * NTHR + tid, NT = G * NTHR;
        float* rr = (float*)(ws + WS_ROPERET);
        for (int i = gt; i < TT * 64; i += NT) { const int pos = i >> 6, f = i & 63; const double ang = (double)pos * pow(10000.0, -(double)f / 64.0); rr[2 * i] = (float)cos(ang); rr[2 * i + 1] = (float)sin(ang); }
        float* r2 = (float*)(ws + WS_ROPER); float* c2 = (float*)(ws + WS_ROPEC);
        for (int i = gt; i < 128 * 16; i += NT) { const int pos = i >> 4, f = i & 15; const double ang = (double)pos * pow(10000.0, -(double)f / 16.0); r2[2 * i] = (float)cos(ang); r2[2 * i + 1] = (float)sin(ang);
            if (pos < 64) { c2[2 * i] = (float)cos(ang); c2[2 * i + 1] = (float)sin(ang); } }
        if (gt == 0) { const float* lm = a.in[I_OLAM]; float s1 = 0.f, s2 = 0.f; for (int i = 0; i < 64; ++i) { s1 += lm[i] * lm[64 + i]; s2 += lm[128 + i] * lm[192 + i]; }
            float gq = 0.f, gk = 0.f; for (int i = 0; i < 64; ++i) { gq = fmaxf(gq, fabsf(a.in[I_OQN][i])); gk = fmaxf(gk, fabsf(a.in[I_OKN][i])); }
            float* sc = (float*)(ws + WS_SCAL); sc[0] = expf(s1) - expf(s2) + LAM_INIT; sc[1] = 8.0f * gq * gk * LOG2E * 1.01f + 0.5f; }
    }
}
constexpr int MOE_CVT_ITEMS = NEXP * 224 * 16 + NEXP * 32 * 56;
__device__ __forceinline__ void moe_weight_convert(const Args& a, LAS unsigned char* lds, int lane, int wave, int lo, int hi, int w, int nw) {
    unsigned char* ws = launder_ptr(a.ws); LAS float* scr = (LAS float*)(lds + wave * 8704);
    constexpr int IGU = NEXP * 224 * 16, IDN = NEXP * 32 * 56;
    if (w < 0) return;
    for (int it = lo + w; it < hi; it += nw) {
        if (it < IGU) { const int e = it / (224 * 16), r = it % (224 * 16), rg = r / 16, kb = r % 16, row = rg * 32, tile = row >> 8, p = row & 255;
            const float* W = (p < 128 ? a.in[I_OEG] : a.in[I_OEU]) + (size_t)e * 1024 * FFE;
            transpose_item(W, FFE, tile * 128 + (p & 127), kb * 64, (bf16*)(ws + R_MOEGU) + (size_t)e * 7168 * 1024, row, 1024, scr, lane); }
        else { const int q = it - IGU, e = q / (32 * 56), r = q % (32 * 56), rg = r / 56, kb = r % 56;
            transpose_item(a.in[I_OED] + (size_t)e * FFE * 1024, 1024, rg * 32, kb * 64, (bf16*)(ws + R_MOEDN) + (size_t)e * 1024 * FFE, rg * 32, FFE, scr, lane); }
    }
}

template <bool COMB> __device__ __forceinline__ void mod_rows(const float* src_lat, const float* src_ctx, bf16* H, const float* gain, const float* modL, int sh_off, int sc_off, int lane, int wave, float* ctx_copy = nullptr) {
    const int gw = blockIdx.x * NWAVES + wave, NGW = gridDim.x * NWAVES; const int nrows = COMB ? MROWS : MLAT;
    f32x4 gv[4];
#pragma unroll
    for (int j = 0; j < 4; ++j) gv[j] = *(const f32x4*)(gain + 4 * lane + 256 * j);
    for (int row = gw; row < nrows; row += NGW) {
        const float* src; int cond; float* cpy = nullptr;
        if (COMB) { const int b = row / TT, t = row % TT; if (t < LCTX) { src = src_ctx + (size_t)(b * LCTX + t) * DM; cond = 4; if (ctx_copy) cpy = ctx_copy + (size_t)(b * LCTX + t) * DM; } else { src = src_lat + (size_t)(b * SEQ + t - LCTX) * DM; cond = b; } }
        else { src = src_lat + (size_t)row * DM; cond = row >> 13; }
        const float* mp = modL + cond * 6144;
        f32x4 v[4]; float ss = 0.f;
#pragma unroll
        for (int j = 0; j < 4; ++j) { v[j] = *(const f32x4*)(src + 4 * lane + 256 * j); ss += (v[j][0] * v[j][0] + v[j][1] * v[j][1]) + (v[j][2] * v[j][2] + v[j][3] * v[j][3]); }
        if (cpy) {
#pragma unroll
            for (int j = 0; j < 4; ++j) *(f32x4*)(cpy + 4 * lane + 256 * j) = v[j]; }
        const float rstd = 1.0f / sqrtf(wave_sum(ss) * (1.0f / DM) + NORM_EPS);
#pragma unroll
        for (int j = 0; j < 4; ++j) { const f32x4 sh = *(const f32x4*)(mp + sh_off + 4 * lane + 256 * j), sc = *(const f32x4*)(mp + sc_off + 4 * lane + 256 * j);
            const f32x4 y = v[j] * rstd * gv[j] * (sc + 1.0f) + sh; v2u w; w.x = pk2(y[0], y[1]); w.y = pk2(y[2], y[3]);
            *(v2u*)(H + (size_t)row * DM + 4 * lane + 256 * j) = w; }
    }
}

__device__ __forceinline__ void mod_rows_part(const float* src_lat, const float* src_ctx, bf16* H, const float* gain, const float* modL, int sh_off, int sc_off, int lane, int sel, int w, int nw) {
    if (w < 0) return;
    const int nrows = sel == 1 ? MLAT : NB * LCTX;
    f32x4 gv[4];
#pragma unroll
    for (int j = 0; j < 4; ++j) gv[j] = *(const f32x4*)(gain + 4 * lane + 256 * j);
    for (int r = w; r < nrows; r += nw) {
        const float* src; int cond, hrow;
        if (sel == 1) { const int b = r >> 13; src = src_lat + (size_t)r * DM; cond = b; hrow = b * TT + LCTX + (r & (SEQ - 1)); }
        else { const int b = r >> 8; src = src_ctx + (size_t)r * DM; cond = 4; hrow = b * TT + (r & (LCTX - 1)); }
        const float* mp = modL + cond * 6144;
        f32x4 v[4]; float ss = 0.f;
#pragma unroll
        for (int j = 0; j < 4; ++j) { v[j] = *(const f32x4*)(src + 4 * lane + 256 * j); ss += (v[j][0] * v[j][0] + v[j][1] * v[j][1]) + (v[j][2] * v[j][2] + v[j][3] * v[j][3]); }
        const float rstd = 1.0f / sqrtf(wave_sum(ss) * (1.0f / DM) + NORM_EPS);
#pragma unroll
        for (int j = 0; j < 4; ++j) { const f32x4 sh = *(const f32x4*)(mp + sh_off + 4 * lane + 256 * j), sc = *(const f32x4*)(mp + sc_off + 4 * lane + 256 * j);
            const f32x4 y = v[j] * rstd * gv[j] * (sc + 1.0f) + sh; v2u wv; wv.x = pk2(y[0], y[1]); wv.y = pk2(y[2], y[3]);
            *(v2u*)(H + (size_t)hrow * DM + 4 * lane + 256 * j) = wv; }
    }
}

__device__ __forceinline__ void s_phase(const Args& a, LAS unsigned char* lds, int tid, int lane, int wave) {
    unsigned char* ws = launder_ptr(a.ws);
    const bf16* BCRAW = (const bf16*)(ws + R_BCRAW); const bf16* RQ = (const bf16*)(ws + R_RQ); const bf16* RK = (const bf16*)(ws + R_RK);
    bf16* CMC = (bf16*)(ws + R_CMC); bf16* Sg = (bf16*)(ws + R_S); bf16* KTg = (bf16*)(ws + R_KT);
    const float* cw = a.in[I_ECONVW]; const float* cb = a.in[I_ECONVB];
    LAS unsigned char* Xq = lds; LAS unsigned char* Xk = lds + 34816;
    for (int u = blockIdx.x; u < NB * NCH * 6; u += gridDim.x) {
        const int b = u / (NCH * 6), rem = u % (NCH * 6), c = rem / 6, kind = rem % 6; const int row0 = b * TT + c * 128;
#pragma unroll
        for (int k = 0; k < 4; ++k) { const int s = (tid >> 4) + 32 * k, cg = tid & 15;
            if (kind >= 2) { const int head = kind - 2;
                *(LAS v4u*)(Xq + s * 272 + cg * 16) = *(const v4u*)(RQ + (size_t)(row0 + s) * 512 + head * 128 + cg * 8);
                *(LAS v4u*)(Xk + s * 272 + cg * 16) = *(const v4u*)(RK + (size_t)(row0 + s) * 512 + head * 128 + cg * 8);
            } else {
                const bool zp = (s == 0) && (c == 0 || c == 2), zn = (s == 127) && (c == 1 || c == NCH - 1);
#pragma unroll
                for (int which = 0; which < 2; ++which) {
                    const int choff = which * 256 + kind * 128 + cg * 8; const bf16* p = BCRAW + (size_t)(row0 + s) * 512 + choff;
                    v4u cur = *(const v4u*)p, prv = {0u, 0u, 0u, 0u}, nxt = {0u, 0u, 0u, 0u};
                    if (!zp) prv = *(const v4u*)(p - 512); if (!zn) nxt = *(const v4u*)(p + 512);
                    const float* w0 = cw + 1024 + choff; const float* w1 = w0 + 1536; const float* w2 = w1 + 1536; const float* bb = cb + 1024 + choff;
                    float o[8];
#pragma unroll
                    for (int j = 0; j < 4; ++j) {
                        o[2 * j] = silu_f(w0[2 * j] * bflo(prv[j]) + w1[2 * j] * bflo(cur[j]) + w2[2 * j] * bflo(nxt[j]) + bb[2 * j]);
                        o[2 * j + 1] = silu_f(w0[2 * j + 1] * bfhi(prv[j]) + w1[2 * j + 1] * bfhi(cur[j]) + w2[2 * j + 1] * bfhi(nxt[j]) + bb[2 * j + 1]); }
                    v4u w; w.x = pk2(o[0], o[1]); w.y = pk2(o[2], o[3]); w.z = pk2(o[4], o[5]); w.w = pk2(o[6], o[7]);
                    *(LAS v4u*)((which ? Xq : Xk) + s * 272 + cg * 16) = w;
                    if (which) *(v4u*)(CMC + (size_t)(row0 + s) * 256 + kind * 128 + cg * 8) = w;
                }
            }
        }
        __syncthreads();
#pragma unroll
        for (int k = 0; k < 4; ++k) { const int task = tid + 512 * k, n = task & 127, s8 = task >> 7; unsigned short e[8];
#pragma unroll
            for (int j = 0; j < 8; ++j) e[j] = *(const LAS unsigned short*)(Xk + (s8 * 8 + j) * 272 + n * 2);
            v4u w; w.x = e[0] | ((unsigned)e[1] << 16); w.y = e[2] | ((unsigned)e[3] << 16); w.z = e[4] | ((unsigned)e[5] << 16); w.w = e[6] | ((unsigned)e[7] << 16);
            *(v4u*)(KTg + (size_t)u * 16384 + n * 128 + s8 * 8) = w; }
        const int r = lane & 31, hh = lane >> 5;
#pragma unroll
        for (int tt = 0; tt < 2; ++tt) { const int idx = 2 * wave + tt, tr = idx >> 2, tc = idx & 3; f32x16 acc;
#pragma unroll
            for (int i = 0; i < 16; ++i) acc[i] = 0.f;
#pragma unroll
            for (int ks = 0; ks < 8; ++ks) { const v4u af = *(const LAS v4u*)(Xq + (tr * 32 + r) * 272 + (16 * ks + 8 * hh) * 2), bfr = *(const LAS v4u*)(Xk + (tc * 32 + r) * 272 + (16 * ks + 8 * hh) * 2);
                acc = MFMA32(af, bfr, acc); }
            bf16* sp = Sg + (size_t)u * 16384 + tc * 32 + r;
#pragma unroll
            for (int i = 0; i < 16; ++i) { const int l = tr * 32 + (i & 3) + 8 * (i >> 2) + 4 * hh; sp[l * 128] = (bf16)f2bf(acc[i]); } }
        __syncthreads();
    }
    { const float* LAg = (const float*)(ws + WS_LA); const float* DTg = (const float*)(ws + WS_DT); float* DEC = (float*)(ws + R_DEC);
      for (int it = blockIdx.x * NWAVES + wave; it < NB * NCH * 16; it += gridDim.x * NWAVES) {
        const int head = it & 15, bc = it >> 4; const int row0 = (bc / NCH) * TT + (bc % NCH) * 128; const int l0 = 2 * lane, l1 = l0 + 1;
        const float* lp = LAg + (size_t)(row0 + l0) * 32 + head; const float* dp = DTg + (size_t)(row0 + l0) * 32 + head;
        const float x0 = lp[0] * LOG2E, x1 = lp[32] * LOG2E, y0 = lp[16] * LOG2E, y1 = lp[48] * LOG2E, df0 = dp[0], df1 = dp[32], db0 = dp[16], db1 = dp[48];
        const float sx = x0 + x1, sy = y0 + y1; float ix = sx, iy = sy;
#pragma unroll
        for (int d = 1; d < 64; d <<= 1) { const float tx = __shfl_up(ix, d), ty = __shfl_up(iy, d); if (lane >= d) { ix += tx; iy += ty; } }
        const float totx = __shfl(ix, 63), toty = __shfl(iy, 63); const float ex = ix - sx, ey = iy - sy;
        const float af0 = ex + x0, af1 = ex + sx, ab0 = toty - ey, ab1 = toty - ey - y0;
        float* o = DEC + (size_t)it * DEC_STRIDE + l0;
        *(f32x2*)(o) = (f32x2){af0, af1}; *(f32x2*)(o + 128) = (f32x2){ab0, ab1};
        *(f32x2*)(o + 256) = (f32x2){af0 - __log2f(df0), af1 - __log2f(df1)}; *(f32x2*)(o + 384) = (f32x2){ab0 - __log2f(db0), ab1 - __log2f(db1)};
        *(f32x2*)(o + 512) = (f32x2){df0 * fast_exp2(totx - af0), df1 * fast_exp2(totx - af1)}; *(f32x2*)(o + 640) = (f32x2){db0 * fast_exp2(toty - ab0), db1 * fast_exp2(toty - ab1)};
        if (lane == 0) *(f32x4*)(DEC + (size_t)it * DEC_STRIDE + 768) = (f32x4){fast_exp2(totx), fast_exp2(toty), 0.f, 0.f};
      } }
}

#define LDS_BARRIER() do { asm volatile("s_waitcnt lgkmcnt(0)" ::: "memory"); __builtin_amdgcn_s_barrier(); asm volatile("" ::: "memory"); } while (0)
struct ScanLane { unsigned qlane, klane, slane, vlane, ylane, y16, dlane, wlane; int b, qld2; float dskip; };
template <bool FWD, bool ISRET> __device__ __forceinline__ void scan_pass(const ARG_AS unsigned char* ws, ARG_AS unsigned char* wsw, LAS unsigned char* lds, const ScanLane& L, int tid, int lane, int wave) {
    LAS unsigned char* VT = lds; LAS unsigned char* HB = lds + 8704;
    LAS float* AF = (LAS float*)(lds + 26112); LAS float* AB = AF + 128; LAS float* AFM = AF + 256; LAS float* ABM = AF + 384; LAS float* SC = AF + 768; LAS float* CW = AF + 784;
    LAS unsigned char* VTW = lds + 32768;
    LAS float* CT = (LAS float*)(lds + 32768 + 8704);
    LAS float* YT = (LAS float*)(lds + 49152);
    const LAS float* AX = FWD ? AF : AB; const LAS float* WVX = AF + (FWD ? 512 : 640);
    const int fr = lane & 15, fq = lane >> 4, b = L.b;
    f32x4 hacc[2]; hacc[0] = (f32x4){0.f, 0.f, 0.f, 0.f}; hacc[1] = hacc[0];
    for (int i = tid; i < 2 * 32 * 136 / 2; i += NTHR) ((LAS unsigned*)HB)[i] = 0u;
    v4u cq[4], cs[4], cvc, cvx, cdec; float cw; v4u cyb = {0u, 0u, 0u, 0u}; unsigned prow0 = 0u;
    v4u nq[4], ns[4], nvc, nvx, ndec; float nw;
    const unsigned dclamp = L.dlane - (tid > 192 ? (unsigned)(tid - 192) * 16u : 0u);
#define SCAN_CHUNK(step_) (FWD ? (step_) : ((step_) == 0 ? 1 : ((step_) == 1 ? 0 : NCH + 1 - (step_))))
#define SCAN_LOAD(step_, Q, S_, VC, VX, DEC_, W_) do { const int c_ = SCAN_CHUNK(step_); const unsigned row0_ = (unsigned)(b * TT + c_ * 128); \
        const ARG_AS unsigned char* qb_ = ws + (size_t)(row0_ * (unsigned)L.qld2); const ARG_AS unsigned char* tb_ = ws + (size_t)((unsigned)((b * NCH + c_) * 6) * 32768u); \
        const ARG_AS unsigned char* vb_ = ws + (size_t)(row0_ * 2048u); const ARG_AS unsigned char* db_ = ws + (size_t)((unsigned)((b * NCH + c_) * 16) * (unsigned)(DEC_STRIDE * 4)); \
        _Pragma("unroll") for (int k = 0; k < 4; ++k) { Q[k] = *(const ARG_AS v4u*)(qb_ + (L.qlane + 64u * k)); if (FWD) S_[k] = *(const ARG_AS v4u*)(tb_ + (L.slane + 64u * k)); } \
        VC = *(const ARG_AS v4u*)(vb_ + L.vlane); \
        if (!ISRET) { const int s_ = tid >> 2; const bool zp_ = (s_ == 0) && (c_ == 0 || c_ == 2), zn_ = (s_ == 127) && (c_ == 1 || c_ == NCH - 1); \
            const bool up_ = lane < 4 && !zp_, dn_ = lane >= 60 && !zn_; const v4u t_ = *(const ARG_AS v4u*)(vb_ + (up_ ? L.vlane - 2048u : (dn_ ? L.vlane + 2048u : L.vlane))); \
            const unsigned keep_ = (up_ || dn_) ? 0xffffffffu : 0u; VX = (v4u){t_.x & keep_, t_.y & keep_, t_.z & keep_, t_.w & keep_}; \
            DEC_ = *(const ARG_AS v4u*)(db_ + dclamp); W_ = *(const ARG_AS float*)(db_ + (L.wlane + (FWD ? 0u : 512u))); } } while (0)
    SCAN_LOAD(0, cq, cs, cvc, cvx, cdec, cw);
    __syncthreads();
    for (int step = 0; step < NCH; ++step) {
        const int c = SCAN_CHUNK(step);
        const unsigned row0 = (unsigned)(b * TT + c * 128);
        LAS unsigned char* HBc = HB + (step & 1) * 8704; LAS unsigned char* HBn = HB + ((step + 1) & 1) * 8704;
        if (!ISRET) { if (tid < 193) *(LAS v4u*)(AF + tid * 4) = cdec; }
        { const int s = tid >> 2, pg = tid & 3; float o[8];
            if (ISRET) {
#pragma unroll
                for (int j = 0; j < 4; ++j) { o[2 * j] = bflo(cvc[j]); o[2 * j + 1] = bfhi(cvc[j]); }
            } else {
                v4u cvp, cvn;
#pragma unroll
                for (int j = 0; j < 4; ++j) { const unsigned up = (unsigned)__shfl_up((int)cvc[j], 4), dn = (unsigned)__shfl_down((int)cvc[j], 4); cvp[j] = lane < 4 ? cvx[j] : up; cvn[j] = lane >= 60 ? cvx[j] : dn; }
                const LAS float* w0 = CW + pg * 8; const LAS float* w1 = w0 + 32; const LAS float* w2 = w0 + 64; const LAS float* bb = w0 + 96;
#pragma unroll
                for (int j = 0; j < 4; ++j) {
                    o[2 * j] = silu_f(w0[2 * j] * bflo(cvp[j]) + w1[2 * j] * bflo(cvc[j]) + w2[2 * j] * bflo(cvn[j]) + bb[2 * j]);
                    o[2 * j + 1] = silu_f(w0[2 * j + 1] * bfhi(cvp[j]) + w1[2 * j + 1] * bfhi(cvc[j]) + w2[2 * j + 1] * bfhi(cvn[j]) + bb[2 * j + 1]); } }
            const float wv = ISRET ? WVX[s] : cw;
#pragma unroll
            for (int j = 0; j < 4; ++j) { const unsigned pa = pkc(o[2 * j], o[2 * j + 1]), pw = pkc(o[2 * j] * wv, o[2 * j + 1] * wv);
                *(LAS unsigned short*)(VT + (pg * 8 + 2 * j) * 272 + s * 2) = (unsigned short)pa; *(LAS unsigned short*)(VT + (pg * 8 + 2 * j + 1) * 272 + s * 2) = (unsigned short)(pa >> 16);
                *(LAS unsigned short*)(VTW + (pg * 8 + 2 * j) * 272 + s * 2) = (unsigned short)pw; *(LAS unsigned short*)(VTW + (pg * 8 + 2 * j + 1) * 272 + s * 2) = (unsigned short)(pw >> 16); } }
        if (step > 0) { const int yr = tid >> 2, yc = (tid & 3) * 8; float yv[8];
#pragma unroll
            for (int q = 0; q < 8; ++q) yv[q] = YT[yr * 33 + yc + q];
            if (FWD) { yv[0] += bflo(cyb.x); yv[1] += bfhi(cyb.x); yv[2] += bflo(cyb.y); yv[3] += bfhi(cyb.y); yv[4] += bflo(cyb.z); yv[5] += bfhi(cyb.z); yv[6] += bflo(cyb.w); yv[7] += bfhi(cyb.w); }
            v4u o4; o4.x = pkc(yv[0], yv[1]); o4.y = pkc(yv[2], yv[3]); o4.z = pkc(yv[4], yv[5]); o4.w = pkc(yv[6], yv[7]);
            *(ARG_AS v4u*)(wsw + (size_t)(prow0 * 4096u) + L.y16) = o4; }
        LDS_BARRIER();
        if (FWD) cyb = *(const ARG_AS v4u*)(ws + (size_t)(row0 * 4096u) + L.y16);
        prow0 = row0;
        v4u ck[4];
        { const ARG_AS unsigned char* tb = ws + (size_t)((unsigned)((b * NCH + c) * 6) * 32768u);
#pragma unroll
          for (int k = 0; k < 4; ++k) ck[k] = *(const ARG_AS v4u*)(tb + (L.klane + 64u * k)); }
        { const int sn = step + 1 < NCH ? step + 1 : step; SCAN_LOAD(sn, nq, ns, nvc, nvx, ndec, nw); }
#define VFR(base, pb, k) (*(const LAS v4u*)((base) + ((pb) * 16 + fr) * 272 + (32 * (k) + 8 * fq) * 2))
        { const float at = SC[FWD ? 0 : 1]; hacc[0] = hacc[0] * at; hacc[1] = hacc[1] * at;
#pragma unroll
            for (int k = 0; k < 4; ++k) { const v4u v0 = VFR(VTW, 0, k), v1 = VFR(VTW, 1, k); hacc[0] = MFMA16(v0, ck[k], hacc[0]); hacc[1] = MFMA16(v1, ck[k], hacc[1]); }
#pragma unroll
            for (int pb = 0; pb < 2; ++pb)
#pragma unroll
                for (int e = 0; e < 4; e += 2) { const unsigned pk = pkc(hacc[pb][e], hacc[pb][e + 1]);
                    *(LAS unsigned short*)(HBn + (pb * 16 + 4 * fq + e) * 272 + (wave * 16 + fr) * 2) = (unsigned short)pk; *(LAS unsigned short*)(HBn + (pb * 16 + 4 * fq + e + 1) * 272 + (wave * 16 + fr) * 2) = (unsigned short)(pk >> 16); } }
        f32x4 yacc[2]; yacc[0] = (f32x4){0.f, 0.f, 0.f, 0.f}; yacc[1] = yacc[0];
#pragma unroll
        for (int pb = 0; pb < 2; ++pb)
#pragma unroll
            for (int k = 0; k < 4; ++k) { const v4u hf = *(const LAS v4u*)(HBc + (pb * 16 + fr) * 272 + (32 * k + 8 * fq) * 2); yacc[pb] = MFMA16(cq[k], hf, yacc[pb]); }
        { const f32x4 av = *(const LAS f32x4*)(AX + wave * 16 + 4 * fq);
#pragma unroll
            for (int e = 0; e < 4; ++e) { const float sc = fast_exp2(av[e]); yacc[0][e] *= sc; yacc[1][e] *= sc; } }
        if (FWD) { const int l = wave * 16 + fr; const float afl = AF[l], abl = AB[l];
#pragma unroll
            for (int k = 0; k < 4; ++k) { const int s0 = 32 * k + 8 * fq; const int thr = l - s0; float m[8];
                const f32x4 fa0 = *(const LAS f32x4*)(AFM + s0), fa1 = *(const LAS f32x4*)(AFM + s0 + 4), ba0 = *(const LAS f32x4*)(ABM + s0), ba1 = *(const LAS f32x4*)(ABM + s0 + 4);
#pragma unroll
                for (int e = 0; e < 8; ++e) { const float afs = e < 4 ? fa0[e & 3] : fa1[e & 3], abs_ = e < 4 ? ba0[e & 3] : ba1[e & 3];
                    const unsigned wsv = cs[k][e >> 1]; const float sv = (e & 1) ? bfhi(wsv) : bflo(wsv);
                    const float arg = (thr >= e) ? afl - afs : abl - abs_;
                    m[e] = sv * fast_exp2(arg); }
                if (thr >= 0 && thr < 8) {
                    const unsigned w01 = (thr & 4) ? ((thr & 2) ? cs[k].w : cs[k].z) : ((thr & 2) ? cs[k].y : cs[k].x); const float sd = (thr & 1) ? bfhi(w01) : bflo(w01);
                    CT[l] = sd * fast_exp2(abl - ABM[l]) + L.dskip; }
                v4u mf; mf.x = pkc(m[0], m[1]); mf.y = pkc(m[2], m[3]); mf.z = pkc(m[4], m[5]); mf.w = pkc(m[6], m[7]);
                { const v4u v0 = VFR(VT, 0, k), v1 = VFR(VT, 1, k); yacc[0] = MFMA16(mf, v0, yacc[0]); yacc[1] = MFMA16(mf, v1, yacc[1]); } __builtin_amdgcn_sched_barrier(0); }
            const f32x4 cv = *(const LAS f32x4*)(CT + wave * 16 + 4 * fq);
#pragma unroll
            for (int pb = 0; pb < 2; ++pb) { const v2u vv = *(const LAS v2u*)(VT + (pb * 16 + fr) * 272 + (wave * 16 + 4 * fq) * 2);
                yacc[pb][0] += cv[0] * bflo(vv.x); yacc[pb][1] += cv[1] * bfhi(vv.x); yacc[pb][2] += cv[2] * bflo(vv.y); yacc[pb][3] += cv[3] * bfhi(vv.y); } }
#pragma unroll
        for (int pb = 0; pb < 2; ++pb)
#pragma unroll
            for (int e = 0; e < 4; ++e) YT[(wave * 16 + 4 * fq + e) * 33 + pb * 16 + fr] = yacc[pb][e];
        LDS_BARRIER();
#pragma unroll
        for (int k = 0; k < 4; ++k) { cq[k] = nq[k]; if (FWD) cs[k] = ns[k]; }
        cvc = nvc; if (!ISRET) { cvx = nvx; cdec = ndec; cw = nw; }
    }
#undef VFR
#undef SCAN_LOAD
#undef SCAN_CHUNK
    { const int yr = tid >> 2, yc = (tid & 3) * 8; float yv[8];
#pragma unroll
      for (int q = 0; q < 8; ++q) yv[q] = YT[yr * 33 + yc + q];
      if (FWD) { yv[0] += bflo(cyb.x); yv[1] += bfhi(cyb.x); yv[2] += bflo(cyb.y); yv[3] += bfhi(cyb.y); yv[4] += bflo(cyb.z); yv[5] += bfhi(cyb.z); yv[6] += bflo(cyb.w); yv[7] += bfhi(cyb.w); }
      v4u o4; o4.x = pkc(yv[0], yv[1]); o4.y = pkc(yv[2], yv[3]); o4.z = pkc(yv[4], yv[5]); o4.w = pkc(yv[6], yv[7]);
      *(ARG_AS v4u*)(wsw + (size_t)(prow0 * 4096u) + L.y16) = o4; }
    asm volatile("s_waitcnt vmcnt(0)" ::: "memory");
    __syncthreads();
}
__device__ __forceinline__ void scan_phase(const Args& a, LAS unsigned char* lds, int tid, int lane, int wave) {
    ARG_AS unsigned char* wsw = launder_ptr(a.ws); const ARG_AS unsigned char* ws = wsw;
    LAS float* AF = (LAS float*)(lds + 26112); LAS float* AB = AF + 128; LAS float* AFM = AF + 256; LAS float* ABM = AF + 384; LAS float* SC = AF + 768; LAS float* CW = AF + 784;
    const int fr = lane & 15, fq = lane >> 4;
    for (int sid = blockIdx.x; sid < 256; sid += gridDim.x) {
        const int xq = sid & 7, jq = sid >> 3; const int b = xq >> 1; const bool isret = jq >= 16;
        const int head = isret ? 2 * (xq & 1) + ((jq - 16) >> 3) : (xq & 1) * 8 + (jq >> 1), ps = isret ? ((jq - 16) & 7) : (jq & 1);
        const int kind = isret ? 2 + head : (head >> 3);
        const int vcol = isret ? head * 256 + ps * 32 : head * 64 + ps * 32;
        const int ycol = isret ? 1024 + head * 256 + ps * 32 : head * 64 + ps * 32;
        const int qld = isret ? 512 : 256;
        ScanLane L;
        L.qlane = (unsigned)(isret ? R_RQ + head * 256 : R_CMC + (head >> 3) * 256) + (unsigned)((wave * 16 + fr) * qld + 8 * fq) * 2u;
        L.klane = (unsigned)R_KT + (unsigned)((wave * 16 + fr) * 128 + 8 * fq) * 2u + (unsigned)kind * 32768u;
        L.slane = (unsigned)R_S + (unsigned)((wave * 16 + fr) * 128 + 8 * fq) * 2u + (unsigned)kind * 32768u;
        L.vlane = (unsigned)(isret ? R_RV : R_XS) + (unsigned)((tid >> 2) * 1024 + vcol + (tid & 3) * 8) * 2u;
        L.ylane = (unsigned)R_Y + (unsigned)((wave * 16 + 4 * fq) * 2048 + ycol + fr) * 2u;
        L.y16 = (unsigned)R_Y + (unsigned)((tid >> 2) * 2048 + ycol + (tid & 3) * 8) * 2u;
        L.dlane = (unsigned)R_DEC + (unsigned)head * (unsigned)(DEC_STRIDE * 4) + (unsigned)tid * 16u;
        L.wlane = (unsigned)R_DEC + (unsigned)head * (unsigned)(DEC_STRIDE * 4) + (unsigned)(512 + (tid >> 2)) * 4u;
        L.b = b; L.qld2 = qld * 2; L.dskip = isret ? 0.f : a.in[I_ED][head];
        __syncthreads();
        if (tid < 128) { const int k = tid >> 5, p = tid & 31; const int ch = vcol + p; CW[tid] = isret ? 0.f : (k < 3 ? a.in[I_ECONVW][k * 1536 + ch] : a.in[I_ECONVB][ch]); }
        if (isret && tid < 128) {
            const float lamf = -__expf(a.in[I_ERETD][head]) * LOG2E, lamb = -__expf(a.in[I_ERETD][4 + head]) * LOG2E; const float l = (float)tid;
            AF[tid] = (l + 1.f) * lamf; AB[tid] = (128.f - l) * lamb; AFM[tid] = (l + 1.f) * lamf; ABM[tid] = (128.f - l) * lamb; AF[512 + tid] = fast_exp2((127.f - l) * lamf); AF[640 + tid] = fast_exp2(l * lamb);
            if (tid == 0) { SC[0] = fast_exp2(128.f * lamf); SC[1] = fast_exp2(128.f * lamb); } }
        if (isret) { scan_pass<false, true>(ws, wsw, lds, L, tid, lane, wave); scan_pass<true, true>(ws, wsw, lds, L, tid, lane, wave); }
        else { scan_pass<false, false>(ws, wsw, lds, L, tid, lane, wave); scan_pass<true, false>(ws, wsw, lds, L, tid, lane, wave); }
    }
}

__device__ __forceinline__ void finish_phase(const Args& a, int lane, int sel, int w, int nw) {
    unsigned char* ws = launder_ptr(a.ws); bf16* Y = (bf16*)(ws + R_Y); const float* gn = a.in[I_ESSDN];
    if (w < 0) return;
    const int nrows = sel == 1 ? MLAT : NB * LCTX;
    for (int r = w; r < nrows; r += nw) {
        const int row = sel == 1 ? (r >> 13) * TT + LCTX + (r & (SEQ - 1)) : (r >> 8) * TT + (r & (LCTX - 1));
        const bf16* Z = sel == 1 ? (const bf16*)(ws + R_Z) + (size_t)row * 1024 : (const bf16*)(ws + R_ZC) + (size_t)r * 1024;
        const bf16* RG = sel == 1 ? (const bf16*)(ws + R_RG) + (size_t)row * 1024 : (const bf16*)(ws + R_RGC) + (size_t)r * 1024;
        bf16* yr = Y + (size_t)row * 2048;
        float v[2][8]; float ss = 0.f;
#pragma unroll
        for (int j = 0; j < 2; ++j) { const int idx = 8 * lane + 512 * j; const v4u yv = *(const v4u*)(yr + idx), zv = *(const v4u*)(Z + idx);
#pragma unroll
            for (int q = 0; q < 4; ++q) { const float a0 = bflo(yv[q]) * silu_f(bflo(zv[q])), a1 = bfhi(yv[q]) * silu_f(bfhi(zv[q])); v[j][2 * q] = a0; v[j][2 * q + 1] = a1; ss += a0 * a0 + a1 * a1; } }
        const float rstd = 1.0f / sqrtf(wave_sum(ss) * (1.0f / 1024.0f) + NORM_EPS);
#pragma unroll
        for (int j = 0; j < 2; ++j) { const int idx = 8 * lane + 512 * j; const f32x4 g0 = *(const f32x4*)(gn + idx), g1 = *(const f32x4*)(gn + idx + 4); v4u w;
            w.x = pk2(v[j][0] * rstd * g0[0], v[j][1] * rstd * g0[1]); w.y = pk2(v[j][2] * rstd * g0[2], v[j][3] * rstd * g0[3]);
            w.z = pk2(v[j][4] * rstd * g1[0], v[j][5] * rstd * g1[1]); w.w = pk2(v[j][6] * rstd * g1[2], v[j][7] * rstd * g1[3]); *(v4u*)(yr + idx) = w; }
#pragma unroll
        for (int j = 0; j < 2; ++j) { const int idx = 8 * lane + 512 * j; const v4u yv = *(const v4u*)(yr + 1024 + idx), gv = *(const v4u*)(RG + idx);
            float y8[8]; float s2 = 0.f;
#pragma unroll
            for (int q = 0; q < 4; ++q) { y8[2 * q] = bflo(yv[q]); y8[2 * q + 1] = bfhi(yv[q]); s2 += y8[2 * q] * y8[2 * q] + y8[2 * q + 1] * y8[2 * q + 1]; }
#pragma unroll
            for (int o = 1; o < 32; o <<= 1) s2 += __shfl_xor(s2, o);
            const float rs = 1.0f / sqrtf(s2 * (1.0f / 256.0f) + NORM_EPS); v4u w;
            w.x = pk2(y8[0] * rs * silu_f(bflo(gv[0])), y8[1] * rs * silu_f(bfhi(gv[0]))); w.y = pk2(y8[2] * rs * silu_f(bflo(gv[1])), y8[3] * rs * silu_f(bfhi(gv[1])));
            w.z = pk2(y8[4] * rs * silu_f(bflo(gv[2])), y8[5] * rs * silu_f(bfhi(gv[2]))); w.w = pk2(y8[6] * rs * silu_f(bflo(gv[3])), y8[7] * rs * silu_f(bfhi(gv[3])));
            *(v4u*)(yr + 1024 + idx) = w; }
    }
}

__device__ __forceinline__ void glds16s(const void* sbase, unsigned voff, unsigned lds_dst) {
    unsigned keep;
    asm volatile("s_mov_b32 %0, m0\n\ts_mov_b32 m0, %3\n\ts_nop 0\n\tglobal_load_lds_dwordx4 %1, %2\n\ts_mov_b32 m0, %0" : "=&s"(keep) : "v"(voff), "s"(sbase), "s"(lds_dst) : "memory");
}
__device__ __forceinline__ float rowsum16(float acc, const f32x16& x) {
    asm volatile("s_nop 1\n\tv_add_f32 %0, %0, %1\n\tv_add_f32 %0, %0, %2\n\tv_add_f32 %0, %0, %3\n\tv_add_f32 %0, %0, %4\n\tv_add_f32 %0, %0, %5\n\tv_add_f32 %0, %0, %6\n\tv_add_f32 %0, %0, %7\n\tv_add_f32 %0, %0, %8\n\t"
                 "v_add_f32 %0, %0, %9\n\tv_add_f32 %0, %0, %10\n\tv_add_f32 %0, %0, %11\n\tv_add_f32 %0, %0, %12\n\tv_add_f32 %0, %0, %13\n\tv_add_f32 %0, %0, %14\n\tv_add_f32 %0, %0, %15\n\tv_add_f32 %0, %0, %16"
                 : "+v"(acc) : "v"(x[0]), "v"(x[1]), "v"(x[2]), "v"(x[3]), "v"(x[4]), "v"(x[5]), "v"(x[6]), "v"(x[7]), "v"(x[8]), "v"(x[9]), "v"(x[10]), "v"(x[11]), "v"(x[12]), "v"(x[13]), "v"(x[14]), "v"(x[15]));
    return acc;
}
__device__ __forceinline__ void attn_phase(const Args& a, LAS unsigned char* lds, int tid, int lane, int wave) {
    unsigned char* ws = launder_ptr(a.ws);
    const bf16* Qg = (const bf16*)(ws + R_Q); const bf16* Kg = (const bf16*)(ws + R_K); const bf16* Vt = (const bf16*)(ws + R_VT); bf16* Og = (bf16*)(ws + R_O);
    const float* scal = (const float*)(ws + WS_SCAL); const float lam = scal[0];
    const float* subln = a.in[I_OSUBLN];
    constexpr int BUF = 32768, NT = TT / 64, NBLK = TT / 32;
    const int r = lane & 31, hh = lane >> 5;
    const int G = gridDim.x;
    const int rho = (lane & ~12) | ((lane & 4) << 1) | ((lane & 8) >> 1);
    const unsigned klane = (unsigned)rho * 2048u + (unsigned)wave * 32u, vlane = (unsigned)lane * (unsigned)(MROWS * 2) + (unsigned)wave * 16u;
#define ATT_BAR() do { asm volatile("" ::: "memory"); __builtin_amdgcn_s_barrier(); asm volatile("" ::: "memory"); } while (0)
    for (int it = 0;; ++it) {
        const long L = (long)it * G + blockIdx.x; if (L >= 1024) break;
        const int pair = (int)(L & 7) + 8 * (int)(L >> 8), qb = (int)((L & 255) >> 3); const int b = pair >> 3, h = pair & 7;
        const size_t qrow = (size_t)b * TT + LCTX + qb * 256 + wave * 32 + r;
        v4u qf[2][4];
#pragma unroll
        for (int sub = 0; sub < 2; ++sub)
#pragma unroll
            for (int ks = 0; ks < 4; ++ks) qf[sub][ks] = *(const v4u*)(Qg + qrow * 1024 + h * 128 + sub * 64 + ks * 16 + hh * 8);
        f32x16 o1[4], o2[4];
#pragma unroll
        for (int vb = 0; vb < 4; ++vb)
#pragma unroll
            for (int i = 0; i < 16; ++i) { o1[vb][i] = 0.f; o2[vb][i] = 0.f; }
        float l1 = 0.f, l2 = 0.f;
        const char* kub = (const char*)(Kg + (size_t)b * TT * 1024 + h * 128);
        const char* vub = (const char*)(Vt + (size_t)(h * 128) * MROWS + (size_t)b * TT);
#define ATT_STAGE(slot, kt) do { const char* kp_ = kub + (size_t)(kt) * (64 * 1024 * 2); const char* vp_ = vub + (size_t)(kt) * 128; const unsigned lb_ = (unsigned)(size_t)lds + (unsigned)(slot) * (unsigned)BUF + (unsigned)wave * 2048u; \
        glds16s(kp_, klane, lb_); glds16s(kp_ + 16, klane, lb_ + 1024u); glds16s(vp_, vlane, lb_ + 16384u); glds16s(vp_ + (size_t)64 * MROWS * 2, vlane, lb_ + 16384u + 1024u); } while (0)
        asm volatile("s_waitcnt vmcnt(0)" ::: "memory");
        __syncthreads();
#pragma unroll
        for (int sub = 0; sub < 2; ++sub)
#pragma unroll
            for (int ks = 0; ks < 4; ++ks) asm volatile("" : "+v"(qf[sub][ks]));
        ATT_STAGE(0, 0); ATT_STAGE(1, 1);
        asm volatile("s_waitcnt vmcnt(0)" ::: "memory");
        ATT_BAR();
        f32x16 s1, s2; v4u pfc[2][2], pfn[2][2];
#pragma unroll
        for (int u0 = 0; u0 < 2; ++u0)
#pragma unroll
            for (int u1 = 0; u1 < 2; ++u1) { pfc[u0][u1] = (v4u){0u, 0u, 0u, 0u}; pfn[u0][u1] = (v4u){0u, 0u, 0u, 0u}; }
        v4u kf[4];
        { LAS unsigned char* kb0 = lds + hh * 1024 + r * 16;
          kf[0] = *(const LAS v4u*)(kb0); kf[1] = *(const LAS v4u*)(kb0 + 8192); kf[2] = *(const LAS v4u*)(kb0 + 2048); kf[3] = *(const LAS v4u*)(kb0 + 8192 + 2048); }
#pragma unroll 1
        for (int j = 0; j < NBLK; ++j) {
            const int jp = j > 0 ? j - 1 : 0, jn = j + 1 < NBLK ? j + 1 : NBLK - 1;
            LAS unsigned char* kbuf = lds + ((j >> 1) % 3) * BUF + hh * 1024 + ((j & 1) * 32 + r) * 16;
            LAS unsigned char* knx = lds + ((jn >> 1) % 3) * BUF + hh * 1024 + ((jn & 1) * 32 + r) * 16;
            LAS unsigned char* vbuf = lds + ((jp >> 1) % 3) * BUF + 16384 + (jp & 1) * 8192 + hh * 2048 + r * 16;
            v4u af;
            {
#pragma unroll
              for (int i = 0; i < 16; ++i) { s1[i] = 0.f; s2[i] = 0.f; }
              s1 = MFMA32(kf[0], qf[0][0], s1); kf[0] = *(const LAS v4u*)(kbuf + 2 * 2048);
              s2 = MFMA32(kf[1], qf[1][0], s2); kf[1] = *(const LAS v4u*)(kbuf + 8192 + 2 * 2048);
              s1 = MFMA32(kf[2], qf[0][1], s1); kf[2] = *(const LAS v4u*)(kbuf + 3 * 2048);
              s2 = MFMA32(kf[3], qf[1][1], s2); kf[3] = *(const LAS v4u*)(kbuf + 8192 + 3 * 2048);
              af = *(const LAS v4u*)(vbuf);
              s1 = MFMA32(kf[0], qf[0][2], s1); s2 = MFMA32(kf[1], qf[1][2], s2); s1 = MFMA32(kf[2], qf[0][3], s1); s2 = MFMA32(kf[3], qf[1][3], s2); }
            __builtin_amdgcn_sched_barrier(0);
            { float e0 = 0.f, e1 = 0.f, f0 = 0.f, f1 = 0.f;
#pragma unroll
              for (int g = 0; g < 8; ++g) { const int vb = g & 3, st = g >> 2; v4u afn = af;
                  if (g < 7) { const int g1 = g + 1, vb1 = g1 & 3, st1 = g1 >> 2; afn = *(const LAS v4u*)(vbuf + st1 * 4096 + (vb1 >> 1) * 1024 + (vb1 & 1) * 512); }
                  if (g >= 4) { const int q = g - 4; kf[q] = *(const LAS v4u*)(knx + (q & 1) * 8192 + (q >> 1) * 2048); }
                  asm volatile("v_add_f32 %0, %0, %2\n\tv_add_f32 %1, %1, %3\n\tv_add_f32 %0, %0, %4\n\tv_add_f32 %1, %1, %5" : "+v"(l1), "+v"(l2) : "v"(e0), "v"(f0), "v"(e1), "v"(f1));
                  o1[vb] = MFMA32(af, pfc[0][st], o1[vb]);
                  e0 = fast_exp2(s1[2 * g]); e1 = fast_exp2(s1[2 * g + 1]);
                  o2[vb] = MFMA32(af, pfc[1][st], o2[vb]);
                  f0 = fast_exp2(s2[2 * g]); f1 = fast_exp2(s2[2 * g + 1]);
                  pfn[0][g >> 2][g & 3] = pkc(e0, e1); pfn[1][g >> 2][g & 3] = pkc(f0, f1);
                  af = afn;
                  __builtin_amdgcn_sched_barrier(0); }
              asm volatile("v_add_f32 %0, %0, %2\n\tv_add_f32 %1, %1, %3\n\tv_add_f32 %0, %0, %4\n\tv_add_f32 %1, %1, %5" : "+v"(l1), "+v"(l2) : "v"(e0), "v"(f0), "v"(e1), "v"(f1)); }
#pragma unroll
            for (int u0 = 0; u0 < 2; ++u0)
#pragma unroll
                for (int u1 = 0; u1 < 2; ++u1) pfc[u0][u1] = pfn[u0][u1];
            if (!(j & 1)) { const int T = j >> 1;
                asm volatile("s_waitcnt vmcnt(0)" ::: "memory");
                ATT_BAR();
                if (T + 2 < NT) ATT_STAGE((T + 2) % 3, T + 2); }
        }
        { const int jp = NBLK - 1; LAS unsigned char* vbuf = lds + ((jp >> 1) % 3) * BUF + 16384 + (jp & 1) * 8192 + hh * 2048 + r * 16;
#pragma unroll
          for (int g = 0; g < 8; ++g) { const int vb = g & 3, st = g >> 2; const v4u af = *(const LAS v4u*)(vbuf + st * 4096 + (vb >> 1) * 1024 + (vb & 1) * 512);
              o1[vb] = MFMA32(af, pfc[0][st], o1[vb]); o2[vb] = MFMA32(af, pfc[1][st], o2[vb]); } }
#undef ATT_STAGE
        l1 += __shfl_xor(l1, 32); l2 += __shfl_xor(l2, 32);
        const float i1 = 1.0f / l1, i2 = lam / l2; float ss = 0.f;
#pragma unroll
        for (int vb = 0; vb < 4; ++vb)
#pragma unroll
            for (int i = 0; i < 16; ++i) { const float o = o1[vb][i] * i1 - o2[vb][i] * i2; o1[vb][i] = o; ss += o * o; }
        ss += __shfl_xor(ss, 32);
        const float rstd = (1.0f - LAM_INIT) / sqrtf(ss * (1.0f / 128.0f) + NORM_EPS);
        bf16* orow = Og + ((size_t)b * SEQ + qb * 256 + wave * 32 + r) * 1024 + h * 128;
#pragma unroll
        for (int vb = 0; vb < 4; ++vb)
#pragma unroll
            for (int g = 0; g < 4; ++g) { const int e = vb * 32 + 8 * g + 4 * hh; const f32x4 sg = *(const f32x4*)(subln + e); v2u w;
                w.x = pk2(o1[vb][4 * g] * rstd * sg[0], o1[vb][4 * g + 1] * rstd * sg[1]); w.y = pk2(o1[vb][4 * g + 2] * rstd * sg[2], o1[vb][4 * g + 3] * rstd * sg[3]);
                *(v2u*)(orow + e) = w; }
    }
#undef ATT_BAR
}

__device__ __forceinline__ void route_phase(const Args& a, LAS unsigned char* lds, int tid, int lane, int wave) {
    unsigned char* ws = launder_ptr(a.ws); bf16* H = (bf16*)(ws + WS_H); const float* gain = a.in[I_ONORM2]; const float* modL = (const float*)(ws + WS_MOD) + 5 * 6144; const float* router = a.in[I_OROUTER];
    int* toke = (int*)(ws + WS_TOKE); int* tokr = (int*)(ws + WS_TOKR); float* tokw = (float*)(ws + WS_TOKW); unsigned* cnt = (unsigned*)(ws + WS_CTL) + CW_CNT;
    int* slott = (int*)(ws + WS_SLOTT);
    for (int i = blockIdx.x * NTHR + tid; i < 2 * MOE_TILES * 256; i += gridDim.x * NTHR) slott[i] = -1;
    LAS int* le = (LAS int*)lds;
    const int G = gridDim.x, chunk = (MLAT + G - 1) / G;
    const int t0 = blockIdx.x * chunk, t1 = (t0 + chunk) < MLAT ? (t0 + chunk) : MLAT;
    f32x4 gv[4];
#pragma unroll
    for (int j = 0; j < 4; ++j) gv[j] = *(const f32x4*)(gain + 4 * lane + 256 * j);
    for (int row = t0 + wave; row < t1; row += NWAVES) {
        const float* src = a.out + (size_t)row * DM; const float* mp = modL + (row >> 13) * 6144;
        f32x4 v[4]; float ss = 0.f;
#pragma unroll
        for (int j = 0; j < 4; ++j) { v[j] = *(const f32x4*)(src + 4 * lane + 256 * j); ss += (v[j][0] * v[j][0] + v[j][1] * v[j][1]) + (v[j][2] * v[j][2] + v[j][3] * v[j][3]); }
        const float rstd = 1.0f / sqrtf(wave_sum(ss) * (1.0f / DM) + NORM_EPS);
        float lg[8] = {0.f, 0.f, 0.f, 0.f, 0.f, 0.f, 0.f, 0.f};
#pragma unroll
        for (int j = 0; j < 4; ++j) { const f32x4 sh = *(const f32x4*)(mp + 3072 + 4 * lane + 256 * j), sc = *(const f32x4*)(mp + 4096 + 4 * lane + 256 * j);
            const f32x4 y = v[j] * rstd * gv[j] * (sc + 1.0f) + sh; v2u w; w.x = pk2(y[0], y[1]); w.y = pk2(y[2], y[3]);
            *(v2u*)(H + (size_t)row * DM + 4 * lane + 256 * j) = w;
#pragma unroll
            for (int q = 0; q < 4; ++q) { const f32x4 r0 = *(const f32x4*)(router + (size_t)(4 * lane + 256 * j + q) * 8), r1 = *(const f32x4*)(router + (size_t)(4 * lane + 256 * j + q) * 8 + 4);
                lg[0] += y[q] * r0[0]; lg[1] += y[q] * r0[1]; lg[2] += y[q] * r0[2]; lg[3] += y[q] * r0[3]; lg[4] += y[q] * r1[0]; lg[5] += y[q] * r1[1]; lg[6] += y[q] * r1[2]; lg[7] += y[q] * r1[3]; } }
#pragma unroll
        for (int e = 0; e < 8; ++e) lg[e] = wave_sum(lg[e]);
        int e0 = 0; float v0 = lg[0];
#pragma unroll
        for (int e = 1; e < 8; ++e) if (lg[e] > v0) { v0 = lg[e]; e0 = e; }
        int e1 = -1; float v1 = -3.0e38f;
#pragma unroll
        for (int e = 0; e < 8; ++e) if (e != e0 && lg[e] > v1) { v1 = lg[e]; e1 = e; }
        if (lane == 0) { const float w0 = 1.0f / (1.0f + __expf(v1 - v0));
            le[row - t0] = e0; le[chunk + row - t0] = e1; toke[row] = e0; toke[MLAT + row] = e1; tokw[row] = w0; tokw[MLAT + row] = 1.0f - w0; }
    }
    __syncthreads();
    if (tid < 16) { const int p = tid >> 3, e = tid & 7; const int n = t1 - t0; int c = 0;
        for (int i = 0; i < n; ++i) c += (le[p * chunk + i] == e) ? 1 : 0;
        int base = 0; if (c > 0) base = (int)__hip_atomic_fetch_add(cnt + 64 * (p * 8 + e), (unsigned)c, RLX_AGENT);
        for (int i = 0; i < n; ++i) if (le[p * chunk + i] == e) tokr[p * MLAT + t0 + i] = base++; }
    __syncthreads();
}
__device__ __forceinline__ void slot_phase(const Args& a, int tid) {
    unsigned char* ws = launder_ptr(a.ws); unsigned* cnt = (unsigned*)(ws + WS_CTL) + CW_CNT; int* meta = (int*)(ws + WS_META);
    const int* toke = (const int*)(ws + WS_TOKE); const int* tokr = (const int*)(ws + WS_TOKR); const float* tokw = (const float*)(ws + WS_TOKW);
    int* slott = (int*)(ws + WS_SLOTT); float* slotw = (float*)(ws + WS_SLOTW);
    int b0[8], b1[8]; int nt0, nt1;
    { int acc = 0;
#pragma unroll
      for (int e = 0; e < 8; ++e) { b0[e] = acc; const int c = (int)__hip_atomic_load(cnt + 64 * e, RLX_AGENT); acc += (c + 255) & ~255; } nt0 = acc >> 8; acc = 0;
#pragma unroll
      for (int e = 0; e < 8; ++e) { b1[e] = acc; const int c = (int)__hip_atomic_load(cnt + 64 * (8 + e), RLX_AGENT); acc += (c + 255) & ~255; } nt1 = acc >> 8; }
    if (blockIdx.x == 0) {
        if (tid < 2) meta[16 + tid] = tid ? nt1 : nt0;
        for (int i = tid; i < 2 * MOE_TILES; i += NTHR) { const int p = i / MOE_TILES, tile = i % MOE_TILES; int e = 0;
#pragma unroll
            for (int q = 1; q < 8; ++q) if (tile * 256 >= (p ? b1[q] : b0[q])) e = q;
            meta[32 + i] = e; }
    }
    for (int t = blockIdx.x * NTHR + tid; t < MLAT; t += gridDim.x * NTHR) {
        { const int e = toke[t]; int bs = 0;
#pragma unroll
          for (int q = 0; q < 8; ++q) if (q == e) bs = b0[q];
          const int slot = bs + tokr[t]; slott[slot] = t; slotw[slot] = tokw[t]; }
        { const int e = toke[MLAT + t]; int bs = 0;
#pragma unroll
          for (int q = 0; q < 8; ++q) if (q == e) bs = b1[q];
          const int slot = bs + tokr[MLAT + t]; slott[MOE_TILES * 256 + slot] = t; slotw[MOE_TILES * 256 + slot] = tokw[MLAT + t]; }
    }
}

constexpr int N_PHASES = 22;
constexpr int MOE_CVT_SPLIT = (MOE_CVT_ITEMS * 2 / 5) & ~15;
constexpr int LDS_BYTES = 147456;
constexpr int MISC_OFF = 131072 + 1024;

template <unsigned MASK> __global__ void __launch_bounds__(NTHR, 2) hybrid_fwd(Args args) {
    extern __shared__ __attribute__((aligned(16))) unsigned char lds_raw[];
    LAS unsigned char* lds = (LAS unsigned char*)lds_raw;
    volatile LAS unsigned* MISC = (volatile LAS unsigned*)(lds + MISC_OFF);
    unsigned* ctl = (unsigned*)(args.ws + WS_CTL);
    if (threadIdx.x < 32) MISC[threadIdx.x] = 0u;
    __syncthreads();
    const int lo = args.ph_lo, hi = args.ph_hi;
    const bool use_bar = (hi - lo) > 1;
    XcdBarrier bar; bar.bar = ctl + CW_BAR; bar.x = 0; bar.st = nullptr;
    if (use_bar) bar = xcd_barrier_post(ctl + CW_BAR, MISC + 8);
#define IN(k) (((MASK >> (k)) & 1u) && lo <= (k) && (k) < hi)
#define SEAM(k) do { if (IN(k) && IN((k) + 1)) xcd_barrier(bar); } while (0)
    const int G = gridDim.x, cid = blockIdx.x;
#define PHASE_PTRS int tid = threadIdx.x; asm volatile("" : "+v"(tid)); const int lane = tid & 63, wave = __builtin_amdgcn_readfirstlane(tid >> 6); (void)lane; (void)wave; unsigned char* ws = launder_ptr(args.ws); float* mod0 = (float*)(ws + WS_MOD); float* mod1 = mod0 + 5 * 6144; const float* gz0 = args.zgate ? (const float*)(ws + WS_CTL + 524288) : mod0; const float* gz1 = args.zgate ? (const float*)(ws + WS_CTL + 524288) : mod1; (void)gz0; (void)gz1; bf16* H = (bf16*)(ws + WS_H); float* XC = (float*)(ws + WS_XC); (void)mod0; (void)mod1; (void)H; (void)XC

    if (IN(0)) { PHASE_PTRS; p0_prologue(args, lds, tid, lane, wave); } SEAM(0);
    if (IN(1)) { PHASE_PTRS; mod_rows<true>(args.in[I_X], args.in[I_CTX], H, args.in[I_ENORM1], mod0, 0, 1024, lane, wave, XC); } SEAM(1);
    if (IN(2)) { PHASE_PTRS;
        pg8::Gemm g{H, (const bf16*)(ws + WS_WINA), MROWS, NA_TILES * 256, 1024}; pg8::StaticOrder S; S.init(MROWS, NA_TILES * 256, G, cid);
        EpiInA E{(bf16*)(ws + R_XS), (bf16*)(ws + R_BCRAW), (bf16*)(ws + R_RQ), (bf16*)(ws + R_RK), (bf16*)(ws + R_RV), (float*)(ws + WS_DT), (float*)(ws + WS_LA),
                 (const float*)(ws + WS_ROPERET), args.in[I_EDTB], args.in[I_EALOG]};
        pg8::gemm_phase<EpiInA, pg8::StaticOrder, true, false>(lds, g, S, E, nullptr);
        { pg8::Gemm g2{H, (const bf16*)(ws + WS_WINB), MROWS, 2048, 1024}; pg8::LatCtxOrder S2; S2.init(G, (cid + G - (132 * NA_TILES) % G) % G, 1024 / 64, 2, 8);
          EpiStore E2{(bf16*)(ws + R_ZC), (bf16*)(ws + R_RGC), 4, 1024, 1024, 33};
          pg8::gemm_phase<EpiStore, pg8::LatCtxOrder, true, false>(lds, g2, S2, E2, nullptr); }
    } SEAM(2);
    if (IN(3)) { PHASE_PTRS; s_phase(args, lds, tid, lane, wave); } SEAM(3);
    if (IN(4)) { PHASE_PTRS; scan_phase(args, lds, tid, lane, wave); } SEAM(4);
    if (IN(5)) { PHASE_PTRS;
        finish_phase(args, lane, 2, cid * NWAVES + wave, G * NWAVES);
        pg8::Gemm g{H, (const bf16*)(ws + WS_WINB), MROWS, 2048, 1024}; pg8::LatCtxOrder S; S.init(G, cid, 1024 / 64, 0, 8);
        EpiStore E{(bf16*)(ws + R_Z), (bf16*)(ws + R_RG), 4, 1024, 1024};
        pg8::gemm_phase<EpiStore, pg8::LatCtxOrder, true, false>(lds, g, S, E, nullptr);
    } SEAM(5);
    if (IN(6)) { PHASE_PTRS;
        { pg8::Gemm g{(const bf16*)(ws + R_Y), (const bf16*)(ws + WS_WOUT0), MROWS, 1024, 2048}; pg8::LatCtxOrder S; S.init(G, cid, 2048 / 64, 2);
          EpiRes<true> E{args.in[I_X], XC, args.out, XC, gz0 + 2048, TailMeet{nullptr, nullptr, MISC + 16}};
          pg8::gemm_phase<EpiRes<true>, pg8::LatCtxOrder, true, false>(lds, g, S, E, nullptr); }
        { const int nb = G > 32 ? 16 : 0; finish_phase(args, lane, 1, cid >= nb ? (cid - nb) * NWAVES + wave : -1, (G - nb) * NWAVES); }
    } SEAM(6);
    if (IN(7)) { PHASE_PTRS;
        pg8::Gemm g{(const bf16*)(ws + R_Y), (const bf16*)(ws + WS_WOUT0), MROWS, 1024, 2048}; pg8::LatCtxOrder S; S.init(G, cid, 2048 / 64, 0);
        EpiRes<true> E{args.in[I_X], XC, args.out, XC, gz0 + 2048, TailMeet{(float*)(ws + R_PART0), (unsigned*)(ws + WS_CTL) + CW_TKT, MISC + 16}};
        pg8::gemm_phase<EpiRes<true>, pg8::LatCtxOrder, true, false>(lds, g, S, E, nullptr);
    } SEAM(7);
    if (IN(8)) { PHASE_PTRS; mod_rows<true>(args.out, XC, H, args.in[I_ENORM2], mod0, 3072, 4096, lane, wave); } SEAM(8);
    if (IN(9)) { PHASE_PTRS;
        pg8::Gemm g{H, (const bf16*)(ws + WS_WGU0), MROWS, 5632, 1024}; pg8::StaticOrder S; S.init(MROWS, 5632, G, cid);
        EpiSwiglu E{(bf16*)(ws + R_HID), FFD, 0, 0};
        pg8::gemm_phase<EpiSwiglu, pg8::StaticOrder, true, false>(lds, g, S, E, nullptr);
    } SEAM(9);
    if (IN(10)) { PHASE_PTRS;
        pg8::Gemm g{(const bf16*)(ws + R_HID), (const bf16*)(ws + WS_WDN0), MROWS, 1024, FFD}; pg8::LatCtxOrder S; S.init(G, cid, FFD / 64, 0);
        EpiRes<true> E{args.out, XC, args.out, XC, gz0 + 5120, TailMeet{(float*)(ws + R_PART0), (unsigned*)(ws + WS_CTL) + CW_TKT + 8192, MISC + 16}};
        pg8::gemm_phase<EpiRes<true>, pg8::LatCtxOrder, true, false>(lds, g, S, E, nullptr);
    } SEAM(10);
    if (IN(11)) { PHASE_PTRS;
        { pg8::Gemm g{(const bf16*)(ws + R_HID), (const bf16*)(ws + WS_WDN0), MROWS, 1024, FFD}; pg8::LatCtxOrder S; S.init(G, cid, FFD / 64, 2);
          EpiRes<true> E{args.out, XC, args.out, XC, gz0 + 5120, TailMeet{nullptr, nullptr, MISC + 16}};
          pg8::gemm_phase<EpiRes<true>, pg8::LatCtxOrder, true, false>(lds, g, S, E, nullptr); }
        { const int nb = G > 32 ? 16 : 0; const int wk = cid >= nb ? (cid - nb) * NWAVES + wave : -1, nwk = (G - nb) * NWAVES;
          mod_rows_part(args.out, XC, H, args.in[I_ONORM1], mod1, 0, 1024, lane, 1, wk, nwk);
          moe_weight_convert(args, lds, lane, wave, 0, MOE_CVT_ITEMS, wk, nwk); }
    } SEAM(11);
    if (IN(12)) { PHASE_PTRS; mod_rows_part(args.out, XC, H, args.in[I_ONORM1], mod1, 0, 1024, lane, 2, cid * NWAVES + wave, G * NWAVES); } SEAM(12);
    if (IN(13)) { PHASE_PTRS;
        { pg8::Gemm g{H, (const bf16*)(ws + WS_WQK), MROWS, 2048, 1024}; pg8::StaticOrder S; S.init(MROWS, 2048, G, cid);
          EpiQK E{(bf16*)(ws + R_Q), (bf16*)(ws + R_K), args.in[I_OQN], args.in[I_OKN], (const float*)(ws + WS_ROPER), (const float*)(ws + WS_ROPEC)};
          pg8::gemm_phase<EpiQK, pg8::StaticOrder, true, false>(lds, g, S, E, nullptr); }
        { pg8::Gemm g{(const bf16*)(ws + WS_WV), H, 1024, MROWS, 1024}; pg8::StaticOrder S; S.init(1024, MROWS, G, (cid + G - 32 % G) % G);
          EpiStore E{(bf16*)(ws + R_VT), (bf16*)(ws + R_VT), 1 << 30, MROWS, MROWS};
          pg8::gemm_phase<EpiStore, pg8::StaticOrder, true, false>(lds, g, S, E, nullptr); }
    } SEAM(13);
    if (IN(14)) { PHASE_PTRS; attn_phase(args, lds, tid, lane, wave); } SEAM(14);
    if (IN(15)) { PHASE_PTRS;
        pg8::Gemm g{(const bf16*)(ws + R_O), (const bf16*)(ws + WS_WO1), MLAT, 1024, 1024}; pg8::StaticOrder S; S.init(MLAT, 1024, G, cid);
        EpiRes<false> E{args.out, nullptr, args.out, nullptr, gz1 + 2048, TailMeet{nullptr, nullptr, MISC + 16}};
        pg8::gemm_phase<EpiRes<false>, pg8::StaticOrder, true, false>(lds, g, S, E, nullptr);
    } SEAM(15);
    if (IN(16)) { PHASE_PTRS; route_phase(args, lds, tid, lane, wave); } SEAM(16);
    if (IN(17)) { PHASE_PTRS; slot_phase(args, tid); } SEAM(17);
    {
        constexpr int HCAP = 4;
        if (IN(18)) { PHASE_PTRS; const int* meta = (const int*)(ws + WS_META); const int* slott = (const int*)(ws + WS_SLOTT);
            pg8::Gemm g{H, (const bf16*)(ws + R_MOEGU), 0, 0, 1024}; pg8::MoeOrder S; S.init(meta[16], 28, G, cid, meta + 32, 0, 0, 0, 0);
            EpiSwiglu E{(bf16*)(ws + R_HID2), FFE, 28, 0};
            pg8::gemm_phase<EpiSwiglu, pg8::MoeOrder, true, true>(lds, g, S, E, slott);
            { const int u0 = meta[16] * 28, rot = u0 % G; const int* slott1 = slott + MOE_TILES * 256;
              pg8::MoeOrder S1; S1.init(meta[17] - 128, 28, G, (cid + G - rot) % G, meta + 32 + MOE_TILES, 128, 8, 0, 0);
              EpiSwiglu E1{(bf16*)(ws + R_HID2), FFE, 28, 8};
              pg8::gemm_phase<EpiSwiglu, pg8::MoeOrder, true, true>(lds, g, S1, E1, slott1); }
        } SEAM(18);
        if (IN(19)) { PHASE_PTRS; const int* meta = (const int*)(ws + WS_META); const int* slott = (const int*)(ws + WS_SLOTT); const float* slotw = (const float*)(ws + WS_SLOTW);
            const int nT = meta[16];
            pg8::Gemm g{(const bf16*)(ws + R_HID2), (const bf16*)(ws + R_MOEDN), 0, 0, FFE}; pg8::MoeOrder S; S.init(nT < 128 ? nT : 128, 4, G, cid, meta + 32, 0, 0, 0, 0);
            EpiMoeDown E{args.out, gz1 + 5120, slott, slotw, TailMeet{nullptr, nullptr, MISC + 16}};
            pg8::gemm_phase<EpiMoeDown, pg8::MoeOrder, true, false>(lds, g, S, E, nullptr);
        } SEAM(19);
        if (IN(20)) { PHASE_PTRS; const int* meta = (const int*)(ws + WS_META);
            const int nTa = meta[16], nleft = nTa > 128 ? (nTa - 128) * 4 : 0;
            { const int* slott = (const int*)(ws + WS_SLOTT); const float* slotw = (const float*)(ws + WS_SLOTW);
              pg8::Gemm g{(const bf16*)(ws + R_HID2), (const bf16*)(ws + R_MOEDN), 0, 0, FFE}; pg8::MoeOrder S; S.init(nTa - 128, 4, G, cid, meta + 32, 128, 0, 0, 0);
              EpiMoeDown E{args.out, gz1 + 5120, slott, slotw, TailMeet{nullptr, nullptr, MISC + 16}};
              pg8::gemm_phase<EpiMoeDown, pg8::MoeOrder, true, false>(lds, g, S, E, nullptr); }
            const int nTb = meta[17], nleftb = nTb > 128 ? (nTb - 128) * 4 : 0;
            { const int* slott = (const int*)(ws + WS_SLOTT) + MOE_TILES * 256; const float* slotw = (const float*)(ws + WS_SLOTW) + MOE_TILES * 256;
              pg8::Gemm g{(const bf16*)(ws + R_HID2), (const bf16*)(ws + R_MOEDN), 0, 0, FFE}; pg8::MoeOrder S; S.init(nTb - 128, 4, G, (cid + G - nleft % G) % G, meta + 32 + MOE_TILES, 128, 8, 0, 0);
              EpiMoeDownScratch E{(float*)(ws + R_MOESCR), gz1 + 5120, slott, slotw};
              pg8::gemm_phase<EpiMoeDownScratch, pg8::MoeOrder, true, false>(lds, g, S, E, nullptr); }
            { const int* slott = (const int*)(ws + WS_SLOTT) + MOE_TILES * 256;
              pg8::Gemm g{H, (const bf16*)(ws + R_MOEGU), 0, 0, 1024}; pg8::MoeOrder S; S.init(nTb < 128 ? nTb : 128, 28, G, cid, meta + 32 + MOE_TILES, 0, 8, nleft + nleftb, HCAP);
              EpiSwiglu E{(bf16*)(ws + R_HID2), FFE, 28, 8};
              pg8::gemm_phase<EpiSwiglu, pg8::MoeOrder, true, true>(lds, g, S, E, slott); }
        } SEAM(20);
        if (IN(21)) { PHASE_PTRS; const int* meta = (const int*)(ws + WS_META); const int* slott = (const int*)(ws + WS_SLOTT) + MOE_TILES * 256; const float* slotw = (const float*)(ws + WS_SLOTW) + MOE_TILES * 256;
            const int nTb = meta[17];
            pg8::Gemm g{(const bf16*)(ws + R_HID2), (const bf16*)(ws + R_MOEDN), 0, 0, FFE}; pg8::MoeOrder S; S.init(nTb < 128 ? nTb : 128, 4, G, cid, meta + 32 + MOE_TILES, 0, 8, 0, 0);
            EpiMoeDown E{args.out, gz1 + 5120, slott, slotw, TailMeet{nullptr, nullptr, MISC + 16}};
            pg8::gemm_phase<EpiMoeDown, pg8::MoeOrder, true, false>(lds, g, S, E, nullptr);
            { const float* scr = (const float*)(ws + R_MOESCR); const int gw = cid * NWAVES + wave, NGW = G * NWAVES;
              for (int s = 128 * 256 + gw; s < nTb * 256; s += NGW) { const int tok = slott[s]; if (tok < 0) continue;
                  float* op = args.out + (size_t)tok * DM; const float* sp = scr + (size_t)(s - 128 * 256) * DM;
#pragma unroll
                  for (int j = 0; j < 4; ++j) { const f32x4 a4 = *(const f32x4*)(op + 4 * lane + 256 * j), b4 = *(const f32x4*)(sp + 4 * lane + 256 * j); *(f32x4*)(op + 4 * lane + 256 * j) = a4 + b4; } } }
        }
    }
#undef IN
#undef SEAM
}

#ifndef PH_MASK
#define PH_MASK 0x3FFFFFu
#endif
typedef void (*kern_t)(Args);
template <int P> struct KTab { static void fill(kern_t* t) { t[P] = hybrid_fwd<(1u << P)>; KTab<P - 1>::fill(t); } };
template <> struct KTab<-1> { static void fill(kern_t*) {} };
extern "C" void kernel_launch(void* const* d_in, const int* in_sizes, int n_in, void* d_out, int out_size, void* d_ws, size_t ws_size, hipStream_t stream) {
    static int grid = 0;
    static kern_t tab[N_PHASES + 1];
    if (grid == 0) {
        if (n_in != N_IN || out_size != MLAT * DM || ws_size < WS_END) { fprintf(stderr, "kernel_launch: unexpected shapes: n_in %d out %d ws %zu (need %zu)\n", n_in, out_size, ws_size, (size_t)WS_END); grid = -1; return; }
        int dev = 0, cus = 0;
        if (hipGetDevice(&dev) != hipSuccess || hipDeviceGetAttribute(&cus, hipDeviceAttributeMultiprocessorCount, dev) != hipSuccess) { grid = -1; return; }
#if MK_N_LAUNCHES == 1
        tab[N_PHASES] = hybrid_fwd<PH_MASK>;
        if (hipFuncSetAttribute((const void*)tab[N_PHASES], hipFuncAttributeMaxDynamicSharedMemorySize, LDS_BYTES) != hipSuccess) { fprintf(stderr, "kernel_launch: hipFuncSetAttribute failed\n"); grid = -1; return; }
#else
        KTab<N_PHASES - 1>::fill(tab);
        for (int p = 0; p < N_PHASES; ++p) if (hipFuncSetAttribute((const void*)tab[p], hipFuncAttributeMaxDynamicSharedMemorySize, LDS_BYTES) != hipSuccess) { fprintf(stderr, "kernel_launch: hipFuncSetAttribute failed\n"); grid = -1; return; }
#endif
        (void)hipGetLastError();
        grid = cus;
    }
    if (grid < 0) return;
    if (hipMemsetAsync((char*)d_ws + WS_CTL, 0, CTL_BYTES, stream) != hipSuccess) { fprintf(stderr, "kernel_launch: memset failed\n"); return; }
    Args a{};
    for (int i = 0; i < N_IN; ++i) a.in[i] = (const ARG_AS float*)d_in[i];
    a.out = (ARG_AS float*)d_out; a.ws = (ARG_AS unsigned char*)d_ws;
#if MK_N_LAUNCHES == 1
    a.ph_lo = 0; a.ph_hi = N_PHASES;
    hipLaunchKernelGGL(tab[N_PHASES], dim3(grid), dim3(NTHR), LDS_BYTES, stream, a);
#else
#ifndef DUP_MASK
#define DUP_MASK 0u
#endif
    for (int p = 0; p < N_PHASES; ++p) { if (!((PH_MASK >> p) & 1u)) continue; a.ph_lo = p; a.ph_hi = p + 1;
#ifndef DUP_COUNT
#define DUP_COUNT 2
#endif
        for (int rep = 0; rep < (((DUP_MASK >> p) & 1u) ? DUP_COUNT : 1); ++rep) { a.zgate = rep ? 1 : 0; hipLaunchKernelGGL(tab[p], dim3(grid), dim3(NTHR), LDS_BYTES, stream, a); } a.zgate = 0; }
#endif
    const hipError_t le = hipPeekAtLastError();
    if (le != hipSuccess) fprintf(stderr, "kernel_launch: launch failed: %s\n", hipGetErrorName(le));
}
```

```cpp
#include <hip/hip_runtime.h>
#include <cstdio>
#include <cstdint>

#ifndef MK_N_LAUNCHES
#define MK_N_LAUNCHES 1
#endif

namespace pg8 {
#define PG8_LAS __attribute__((address_space(3)))
typedef unsigned short bf16_t;
typedef short bf16x8 __attribute__((ext_vector_type(8)));
typedef float f32x4 __attribute__((ext_vector_type(4)));
typedef unsigned u32x4 __attribute__((ext_vector_type(4)));
typedef unsigned u32x2 __attribute__((ext_vector_type(2)));
constexpr int BM = 256, BK = 64, HALF = 128, HTB = HALF * BK * 2  , STAGE_BYTES = 8 * HTB, NXCD = 8, WGM = 8;

__host__ __device__ __forceinline__ int lds_byte(int r, int c) { const int st = (r >> 4) * 2 + (c >> 5), rr = r & 15, cc = c & 31, ob = rr * 64 + cc * 2; return st * 1024 + (ob ^ (((ob >> 9) & 1) << 5)); }
__host__ __device__ __forceinline__ void stage_rc(int b, int& R, int& C) { const int st = b / 1024, sb = b % 1024, swz = sb ^ (((sb >> 9) & 1) << 5); R = (st >> 1) * 16 + swz / 64; C = (st & 1) * 32 + (swz % 64) / 2; }
__host__ __device__ __forceinline__ int perm32(int rho) { const int n = rho >> 4, i = rho & 15; return 8 * (i >> 2) + 4 * n + (i & 3); }

struct Unit { int pm, pn, kt0, nkt, split, tq, sl, nsl; };
struct Gemm { const bf16_t* A; const bf16_t* Bt; int M, N, K; };

struct StaticOrder {
    int nM, nN, nwg, G, c;
    __host__ __device__ void init(int M, int N, int G_, int c_) { nM = M / BM; nN = N / BM; nwg = nM * nN; G = G_; c = c_; }
    __host__ __device__ __forceinline__ bool next(int i, Unit& u) const {
        const long L = (long)i * G + c; if (L >= nwg) return false;
        int wgid = (int)L; { const int q = nwg / NXCD, r = nwg % NXCD, xcd = wgid % NXCD, off = wgid / NXCD; wgid = (xcd < r ? xcd * (q + 1) : r * (q + 1) + (xcd - r) * q) + off; }
        const int nig = WGM * nN, gid = wgid / nig, fm = gid * WGM, gsz = (nM - fm) < WGM ? (nM - fm) : WGM;
        u.pm = fm + ((wgid % nig) % gsz); u.pn = (wgid % nig) / gsz; u.kt0 = 0; u.nkt = 0; u.split = 0; u.tq = 0; u.sl = 0; u.nsl = 1; return true;
    }
    __host__ __device__ __forceinline__ int arow(const Unit& u) const { return u.pm; }
};
constexpr bool TAIL_SPLIT = false;
constexpr int TAIL_MAX_PARTS = 96;
struct TailSplit {
    int nsl, pairs_s, pairs;
    __device__ __forceinline__ void init(int r, int G, int nt, int cap) { pairs = nt >> 1; int sp = r > 0 ? G / r : 1; if (sp > cap) sp = cap; if (r > 0 && sp * r > TAIL_MAX_PARTS) sp = TAIL_MAX_PARTS / r; if (sp < 1) sp = 1; if (sp > pairs) sp = pairs; pairs_s = (pairs + sp - 1) / sp; nsl = (pairs + pairs_s - 1) / pairs_s; }
    __device__ __forceinline__ void slice(int s, int q, Unit& u) const { const int p0 = s * pairs_s, p1 = (p0 + pairs_s) < pairs ? (p0 + pairs_s) : pairs; u.kt0 = 2 * p0; u.nkt = 2 * (p1 - p0); u.split = nsl > 1 ? 1 : 0; u.tq = q; u.sl = s; u.nsl = nsl; }
};
struct MoeOrder {
    int nT, nN, G, c; const int* texp; int t0, shift, nL, H;
    __device__ __forceinline__ void init(int nT_, int nN_, int G_, int c_, const int* texp_, int t0_, int shift_, int nL_, int H_) {
        nT = nT_ < 0 ? 0 : nT_; nN = nN_; G = G_; c = c_; texp = texp_; t0 = t0_; shift = shift_; nL = (nL_ > 0 && nL_ < G_) ? nL_ : 0; H = H_; }
    __device__ __forceinline__ bool next(int i, Unit& u) const {
        const long U = (long)nT * nN; long L;
        if (nL > 0) { const int W = G - nL; const long early = (long)H * W;
            if (c >= nL) L = (i < H) ? (long)i * W + (c - nL) : early + (long)(i - H) * G + c;
            else L = early + (long)i * G + c; }
        else L = (long)i * G + c;
        if (L >= U) return false;
        const int l = (int)L, nig = WGM * nN, gid = l / nig, fm = gid * WGM, gsz = (nT - fm) < WGM ? (nT - fm) : WGM, rem = l % nig;
        const int tile = t0 + fm + rem % gsz, jn = rem / gsz;
        u.pm = tile; u.pn = texp[tile] * nN + jn; u.kt0 = 0; u.nkt = 0; u.split = 0; u.tq = 0; u.sl = 0; u.nsl = 1; return true;
    }
    __device__ __forceinline__ int arow(const Unit& u) const { return u.pm < 128 ? u.pm : u.pm + shift; }
};
struct LatCtxOrder {
    int G, c, mode, nN, nlat, so_nt; TailSplit ts; StaticOrder so;
    __device__ __forceinline__ void init(int G_, int c_, int nt, int mode_ = 1, int nN_ = 4) { G = G_; c = c_; mode = mode_; nN = nN_; nlat = 128 * nN_; so_nt = nt; so.init(128 * BM, nN_ * BM, G_, c_); ts.init(16, G_, nt, 8); if (!TAIL_SPLIT) { ts.nsl = 1; ts.pairs_s = ts.pairs; } }
    __device__ __forceinline__ bool next(int i, Unit& u) const {
        const long L = (long)i * G + c;
        if (mode < 2 && L < nlat) { so.next(i, u); const int vm = u.pm; u.pm = (vm >> 5) * 33 + 1 + (vm & 31); return true; }
        if (mode == 0) return false;
        if (mode == 3) { const int q = (int)(L >> 1), sl = (int)(L & 1); if (q >= 4 * nN) return false; const int half = (so_nt >> 1);
            u.pm = (q / nN) * 33; u.pn = q % nN; u.kt0 = sl * half; u.nkt = half; u.split = 0; u.tq = q; u.sl = sl; u.nsl = 2; return true; }
        const long j = mode == 2 ? L : L - nlat; const int q = (int)(j / ts.nsl), sl = (int)(j % ts.nsl); if (q >= 4 * nN) return false;
        u.pm = (q / nN) * 33; u.pn = q % nN; u.kt0 = 0; u.nkt = 0; u.split = 0; u.tq = 0; u.sl = 0; u.nsl = 1; if (TAIL_SPLIT) ts.slice(sl, q, u); return true;
    }
    __device__ __forceinline__ int arow(const Unit& u) const { return u.pm; }
};

__device__ __forceinline__ unsigned cvt_pk_bf16(float lo, float hi) { unsigned r; asm volatile("v_cvt_pk_bf16_f32 %0, %1, %2" : "=v"(r) : "v"(lo), "v"(hi)); return r; }

template <class Epi, class Sched, bool ALIGN_EPI, bool GATHER>
__device__ __forceinline__ void gemm_phase(PG8_LAS unsigned char* lds, const Gemm g, const Sched& S, const Epi& E, const int* gidx) {
    int tid_ = threadIdx.x; asm volatile("" : "+v"(tid_));
    const int tid = tid_, wid = __builtin_amdgcn_readfirstlane(tid >> 6), lane = tid & 63, wr = wid >> 2, wc = wid & 3, fr = lane & 15, fq = lane >> 4;
    const int K = g.K, nt = K / BK;
    unsigned voffB[2]; int RA[2]; unsigned colA[2];
#pragma unroll
    for (int i = 0; i < 2; ++i) { int R, C; stage_rc(tid * 16 + i * 8192, R, C); const int Rb = Epi::PERM ? ((R & ~31) + perm32(R & 31)) : R;
        RA[i] = R; colA[i] = (unsigned)C * 2u; voffB[i] = (unsigned)(Rb * K + C) * 2u; }
    const size_t kstep = (size_t)(BK * 2);
    const size_t hstep = (size_t)HALF * K * 2;
    const size_t tstep = 2 * hstep;
    const unsigned ldsw = (unsigned)wid * 1024u;
    const int aoff = lds_byte(wr * 64 + fr, fq * 8), boff = lds_byte(wc * 32 + fr, fq * 8);
#define PG8_SA(b, h) (((b) * 2 + (h)) * HTB)
#define PG8_SB(b, h) ((4 + (b) * 2 + (h)) * HTB)
#define PG8_STAGE(bufoff, gbase, voff) do { _Pragma("unroll") for (int _i = 0; _i < 2; ++_i) \
        __builtin_amdgcn_global_load_lds((const unsigned*)((const char*)(gbase) + (voff)[_i]), (PG8_LAS unsigned*)(lds + (bufoff) + ldsw + _i * 8192), 16, 0, 0); } while (0)
#define PG8_STAGE_A(bufoff, gbase, o, h) do { _Pragma("unroll") for (int _i = 0; _i < 2; ++_i) \
        __builtin_amdgcn_global_load_lds((const unsigned*)((const char*)(gbase) + (o)[h][_i]), (PG8_LAS unsigned*)(lds + (bufoff) + ldsw + _i * 8192), 16, 0, 0); } while (0)
#define PG8_SETOFF(o, u) do { _Pragma("unroll") for (int _h = 0; _h < 2; ++_h) _Pragma("unroll") for (int _i = 0; _i < 2; ++_i) { \
        if constexpr (GATHER) { int _t = gidx[(u).pm * BM + _h * HALF + RA[_i]]; _t = _t < 0 ? 0 : _t; (o)[_h][_i] = (unsigned)_t * (unsigned)(K * 2) + colA[_i]; } \
        else { (o)[_h][_i] = (unsigned)(_h * HALF + RA[_i]) * (unsigned)(K * 2) + colA[_i]; } } } while (0)
#define PG8_LDA(dst, b, h) do { _Pragma("unroll") for (int m = 0; m < 4; ++m) _Pragma("unroll") for (int k = 0; k < 2; ++k) dst[m][k] = *(const PG8_LAS bf16x8*)(lds + PG8_SA(b, h) + aoff + m * 2048 + k * 1024); } while (0)
#define PG8_LDB(dst, b, h) do { _Pragma("unroll") for (int n = 0; n < 2; ++n) _Pragma("unroll") for (int k = 0; k < 2; ++k) dst[n][k] = *(const PG8_LAS bf16x8*)(lds + PG8_SB(b, h) + boff + n * 2048 + k * 1024); } while (0)
#ifndef PG8_PRIO
#define PG8_PRIO 1
#endif
#define PG8_MMA(ai, bj, At, Bt) do { if (PG8_PRIO) __builtin_amdgcn_s_setprio(1); _Pragma("unroll") for (int m = 0; m < 4; ++m) _Pragma("unroll") for (int n = 0; n < 2; ++n) _Pragma("unroll") for (int k = 0; k < 2; ++k) \
        acc[ai][bj][m][n] = __builtin_amdgcn_mfma_f32_16x16x32_bf16(Bt[n][k], At[m][k], acc[ai][bj][m][n], 0, 0, 0); if (PG8_PRIO) __builtin_amdgcn_s_setprio(0); } while (0)
#define PG8_WAIT_V(n) asm volatile("s_waitcnt vmcnt(" #n ")" ::: "memory")
#define PG8_WAIT_L(n) asm volatile("s_waitcnt lgkmcnt(" #n ")" ::: "memory")
#define PG8_BAR __builtin_amdgcn_s_barrier()
#define PG8_SCHED __builtin_amdgcn_sched_barrier(0)
    Unit cur, nxt;
    int ui = 0;
    if (!S.next(0, cur)) return;
    f32x4 acc[2][2][4][2];
#pragma unroll
    for (int a = 0; a < 2; ++a)
#pragma unroll
        for (int b = 0; b < 2; ++b)
#pragma unroll
            for (int m = 0; m < 4; ++m)
#pragma unroll
                for (int n = 0; n < 2; ++n) acc[a][b][m][n] = (f32x4){0.f, 0.f, 0.f, 0.f};
    bf16x8 At[4][2], B0[2][2], B1[2][2];
    unsigned oc[2][2], on[2][2];
    PG8_SETOFF(oc, cur);
    if (cur.nkt == 0) cur.nkt = nt;
    const char* cA = (GATHER ? (const char*)g.A : (const char*)g.A + (size_t)S.arow(cur) * tstep) + (size_t)cur.kt0 * kstep; const char* cB = (const char*)g.Bt + (size_t)cur.pn * tstep + (size_t)cur.kt0 * kstep;
    PG8_STAGE(PG8_SB(0, 0), cB, voffB); PG8_STAGE(PG8_SB(0, 1), cB + hstep, voffB); PG8_STAGE_A(PG8_SA(0, 0), cA, oc, 0); PG8_STAGE_A(PG8_SA(0, 1), cA, oc, 1);
    if (wr == 1) PG8_BAR;
    PG8_WAIT_V(2); PG8_BAR;
    PG8_STAGE(PG8_SB(1, 0), cB + kstep, voffB); PG8_STAGE_A(PG8_SA(1, 0), cA + kstep, oc, 0); PG8_STAGE(PG8_SB(1, 1), cB + hstep + kstep, voffB);
    PG8_WAIT_V(6); PG8_BAR;
    for (;;) {
        const bool has_next = S.next(ui + 1, nxt);
        if (has_next) { if (nxt.nkt == 0) nxt.nkt = nt; PG8_SETOFF(on, nxt); } else {
#pragma unroll
            for (int h = 0; h < 2; ++h)
#pragma unroll
                for (int i = 0; i < 2; ++i) on[h][i] = oc[h][i]; }
        const char* nA = has_next ? (GATHER ? (const char*)g.A : (const char*)g.A + (size_t)S.arow(nxt) * tstep) + (size_t)nxt.kt0 * kstep : cA; const char* nB = has_next ? (const char*)g.Bt + (size_t)nxt.pn * tstep + (size_t)nxt.kt0 * kstep : cB;
        const int ntc = cur.nkt;
        for (int t = 0; t < ntc; t += 2) {
            const bool last = (t == ntc - 2);
            const char* a1 = cA + (size_t)(t + 1) * kstep;
            const char* a2 = last ? nA : cA + (size_t)(t + 2) * kstep; const char* b2 = last ? nB : cB + (size_t)(t + 2) * kstep;
            const char* a3 = a2 + kstep; const char* b3 = b2 + kstep;
            unsigned o2[2][2];
#pragma unroll
            for (int h = 0; h < 2; ++h)
#pragma unroll
                for (int i = 0; i < 2; ++i) o2[h][i] = last ? on[h][i] : oc[h][i];
            PG8_LDB(B0, 0, 0); PG8_LDB(B1, 0, 1); PG8_SCHED; PG8_LDA(At, 0, 0); PG8_STAGE_A(PG8_SA(1, 1), a1, oc, 1);
            PG8_WAIT_V(8); PG8_WAIT_L(0); PG8_BAR; PG8_MMA(0, 0, At, B0); PG8_MMA(0, 1, At, B1); PG8_BAR; PG8_SCHED;
            PG8_LDA(At, 0, 1); PG8_STAGE(PG8_SB(0, 0), b2, voffB); PG8_STAGE(PG8_SB(0, 1), b2 + hstep, voffB); PG8_STAGE_A(PG8_SA(0, 0), a2, o2, 0);
            PG8_WAIT_V(8); PG8_WAIT_L(0); PG8_BAR; PG8_MMA(1, 0, At, B0); PG8_MMA(1, 1, At, B1); PG8_BAR; PG8_SCHED;
            PG8_LDB(B0, 1, 0); PG8_LDB(B1, 1, 1); PG8_SCHED; PG8_LDA(At, 1, 0); PG8_STAGE_A(PG8_SA(0, 1), a2, o2, 1);
            PG8_WAIT_V(8); PG8_WAIT_L(0); PG8_BAR; PG8_MMA(0, 0, At, B0); PG8_MMA(0, 1, At, B1); PG8_BAR; PG8_SCHED;
            PG8_LDA(At, 1, 1); PG8_STAGE(PG8_SB(1, 0), b3, voffB); PG8_STAGE(PG8_SB(1, 1), b3 + hstep, voffB); PG8_STAGE_A(PG8_SA(1, 0), a3, o2, 0);
            PG8_WAIT_V(8); PG8_WAIT_L(0); PG8_BAR; PG8_MMA(1, 0, At, B0); PG8_MMA(1, 1, At, B1); PG8_BAR; PG8_SCHED;
        }
        if constexpr (ALIGN_EPI) { if (wr == 0) PG8_BAR; }
        E(acc, cur, wr, wc, fr, fq);
        if (!has_next) break;
#pragma unroll
        for (int a = 0; a < 2; ++a)
#pragma unroll
            for (int b = 0; b < 2; ++b)
#pragma unroll
                for (int m = 0; m < 4; ++m)
#pragma unroll
                    for (int n = 0; n < 2; ++n) acc[a][b][m][n] = (f32x4){0.f, 0.f, 0.f, 0.f};
        cur = nxt; cA = nA; cB = nB; ++ui;
#pragma unroll
        for (int h = 0; h < 2; ++h)
#pragma unroll
            for (int i = 0; i < 2; ++i) oc[h][i] = on[h][i];
        if constexpr (ALIGN_EPI) { if (wr == 1) PG8_BAR; }
    }
    PG8_WAIT_V(0);
    if constexpr (!ALIGN_EPI) { if (wr == 0) PG8_BAR; }
    PG8_BAR;
#undef PG8_SA
#undef PG8_SB
#undef PG8_STAGE
#undef PG8_STAGE_A
#undef PG8_SETOFF
#undef PG8_LDA
#undef PG8_LDB
#undef PG8_MMA
#undef PG8_WAIT_V
#undef PG8_WAIT_L
#undef PG8_BAR
#undef PG8_SCHED
}
}

constexpr int NWAVES = 8, NTHR = 512;
constexpr int NB = 4, SEQ = 8192, LCTX = 256, TT = SEQ + LCTX  , MROWS = NB * TT  , MLAT = NB * SEQ, DM = 1024;
constexpr int PPB = TT / 256;
constexpr int NCH = TT / 128;
constexpr int EVEN_IN = 5664, FFD = 2816, FFE = 3584, NEXP = 8;
constexpr int NA_TILES = 15;
constexpr int MOE_TILES = 136;
constexpr int MOE_HID_TILES = 144;
constexpr float NORM_EPS = 1e-6f;
constexpr float LAM_INIT = 0.35550906759096926f;
constexpr float LOG2E = 1.4426950408889634f;

constexpr size_t al256(size_t x) { return (x + 255) & ~(size_t)255; }
constexpr size_t WS_CTL = 0, CTL_BYTES = 1u << 20;
constexpr size_t WS_MOD = WS_CTL + CTL_BYTES;
constexpr size_t WS_SCAL = WS_MOD + al256(2 * 5 * 6144 * 4);
constexpr size_t WS_ROPER = WS_SCAL + 4096;
constexpr size_t WS_ROPEC = WS_ROPER + 128 * 16 * 8;
constexpr size_t WS_META = WS_ROPEC + 64 * 16 * 8;
constexpr size_t WS_ROPERET = WS_META + 4096;
constexpr size_t WS_WINA = WS_ROPERET + al256((size_t)TT * 64 * 8);
constexpr size_t WS_WINB = WS_WINA + (size_t)3840 * 1024 * 2;
constexpr size_t WS_WOUT0 = WS_WINB + (size_t)2048 * 1024 * 2;
constexpr size_t WS_WGU0 = WS_WOUT0 + (size_t)1024 * 2048 * 2;
constexpr size_t WS_WDN0 = WS_WGU0 + (size_t)5632 * 1024 * 2;
constexpr size_t WS_WQK = WS_WDN0 + (size_t)1024 * 2816 * 2;
constexpr size_t WS_WV = WS_WQK + (size_t)2048 * 1024 * 2;
constexpr size_t WS_WO1 = WS_WV + (size_t)1024 * 1024 * 2;
constexpr size_t WS_XC = WS_WO1 + (size_t)1024 * 1024 * 2;
constexpr size_t WS_DT = WS_XC + (size_t)1024 * 1024 * 4;
constexpr size_t WS_LA = WS_DT + (size_t)MROWS * 32 * 4;
constexpr size_t WS_TOKE = WS_LA + (size_t)MROWS * 32 * 4;
constexpr size_t WS_TOKR = WS_TOKE + (size_t)2 * MLAT * 4;
constexpr size_t WS_TOKW = WS_TOKR + (size_t)2 * MLAT * 4;
constexpr size_t WS_SLOTT = WS_TOKW + (size_t)2 * MLAT * 4;
constexpr size_t WS_SLOTW = WS_SLOTT + (size_t)2 * MOE_TILES * 256 * 4;
constexpr size_t WS_H = al256(WS_SLOTW + (size_t)2 * MOE_TILES * 256 * 4);
constexpr size_t WS_R = WS_H + (size_t)MROWS * 1024 * 2;
constexpr size_t MiB = 1u << 20;
constexpr size_t R_XS = WS_R, R_RV = WS_R + 66 * MiB, R_Y = WS_R + 132 * MiB, R_BCRAW = R_Y, R_RK = R_Y + 33 * MiB;
constexpr size_t R_S = WS_R + 264 * MiB, R_KT = R_S + (size_t)NB * NCH * 6 * 32768, R_CMC = R_KT + (size_t)NB * NCH * 6 * 32768, R_RQ = R_CMC + (size_t)MROWS * 256 * 2;
constexpr size_t R_DEC = R_RQ + 33 * MiB;
constexpr int DEC_STRIDE = 784;
constexpr size_t R_Z = R_S, R_RG = R_S + 66 * MiB;
constexpr size_t R_ZC = WS_R + 426 * MiB, R_RGC = R_ZC + 2 * MiB;
constexpr size_t R_HID = WS_R;
constexpr size_t R_CTXPART = WS_R + 200 * MiB;
constexpr size_t R_PART0 = WS_R + 264 * MiB;
constexpr size_t R_PART1 = WS_R + 239 * MiB;
constexpr size_t R_MOESCR = WS_R + 252 * MiB;
static_assert(R_RG + 66 * MiB <= R_RQ + 33 * MiB, "gate buffers alias dead scan buffers");
constexpr size_t R_Q = WS_R, R_K = WS_R + 66 * MiB, R_VT = WS_R + 132 * MiB, R_O = WS_R + 198 * MiB;
constexpr size_t R_MOEGU = WS_R + 264 * MiB, R_MOEDN = R_MOEGU + (size_t)NEXP * 7168 * 1024 * 2;
constexpr size_t R_HID2 = WS_R;
constexpr size_t WS_END = R_MOEDN + (size_t)NEXP * 1024 * FFE * 2;
static_assert((size_t)MOE_HID_TILES * 256 * FFE * 2 <= 264 * MiB && (size_t)MOE_TILES * 256 * FFE * 2 <= 239 * MiB && R_PART1 + (size_t)96 * 262144 <= R_MOEGU && (size_t)MOE_TILES * 256 * FFE * 2 <= 264 * MiB && R_DEC + (size_t)NB * NCH * 16 * DEC_STRIDE * 4 <= R_ZC && R_RGC + 2 * MiB <= WS_END, "map");
constexpr int CW_TMO = 0, CW_BAR = 4096, CW_CNT = 8192, CW_TKT = 16384;

#define GAS __attribute__((address_space(1)))
#define LAS __attribute__((address_space(3)))
typedef unsigned short bf16;
typedef unsigned v4u __attribute__((ext_vector_type(4)));
typedef unsigned v2u __attribute__((ext_vector_type(2)));
typedef float f32x4 __attribute__((ext_vector_type(4)));
typedef float f32x2 __attribute__((ext_vector_type(2)));
typedef float f32x16 __attribute__((ext_vector_type(16)));
typedef short bf16x8 __attribute__((ext_vector_type(8)));
#define RLX_AGENT __ATOMIC_RELAXED, __HIP_MEMORY_SCOPE_AGENT
__device__ __forceinline__ unsigned f2bf(float f) { unsigned u = __builtin_bit_cast(unsigned, f); return (u + 0x7fffu + ((u >> 16) & 1u)) >> 16; }
__device__ __forceinline__ unsigned pk2(float lo, float hi) { return pg8::cvt_pk_bf16(lo, hi); }
__device__ __forceinline__ float bf2f(unsigned short b) { return __builtin_bit_cast(float, (unsigned)b << 16); }
__device__ __forceinline__ float bflo(unsigned w) { return __builtin_bit_cast(float, w << 16); }
__device__ __forceinline__ float bfhi(unsigned w) { return __builtin_bit_cast(float, w & 0xffff0000u); }
__device__ __forceinline__ float fast_rcp(float x) { return __builtin_amdgcn_rcpf(x); }
__device__ __forceinline__ float fast_exp2(float x) { return __builtin_amdgcn_exp2f(x); }
__device__ __forceinline__ float silu_f(float x) { return x * fast_rcp(1.0f + fast_exp2(-LOG2E * x)); }
__device__ __forceinline__ float wave_sum(float v) {
#pragma unroll
    for (int o = 1; o < 64; o <<= 1) v += __shfl_xor(v, o);
    return v;
}

#define XB_TMO      128
#define XB_XCNT(j)  (256  + 64 * (j))
#define XB_XSUB(j)  (1280 + 64 * (j))
#define XB_XGEN(j)  (2304 + 64 * (j))
#define XB_TOP      3328
#define XB_TOPGEN   3392
#define XCD_BAR_WORDS 3456
#define XB_SPIN_CAP (1u << 18)
__device__ __forceinline__ unsigned xb_ld(unsigned* p)              { return __hip_atomic_load(p, __ATOMIC_RELAXED, __HIP_MEMORY_SCOPE_AGENT); }
__device__ __forceinline__ unsigned xb_add(unsigned* p, unsigned v) { return __hip_atomic_fetch_add(p, v, __ATOMIC_RELAXED, __HIP_MEMORY_SCOPE_AGENT); }
__device__ __forceinline__ unsigned xb_xcc_id() { return (unsigned)__builtin_amdgcn_s_getreg((3 << 11) | 20) & 0xFu; }
#define XB_SPIN(cond, bar) do { unsigned _sp = 0; while (cond) { __builtin_amdgcn_s_sleep(1); \
    if ((++_sp & 255u) == 0u) { if (xb_ld(&(bar)[XB_TMO])) break; if (_sp > XB_SPIN_CAP) { atomicAdd(&(bar)[XB_TMO], 1u); break; } } } } while (0)
struct XcdBarrier { unsigned* bar; unsigned x; volatile LAS unsigned* st; };
__device__ __forceinline__ XcdBarrier xcd_barrier_post(unsigned* bar, volatile LAS unsigned* st) {
    XcdBarrier b; b.bar = bar; b.x = xb_xcc_id(); b.st = st;
    if (threadIdx.x == 0) (void)xb_add(&bar[XB_XCNT(b.x)], 1u);
    return b;
}
__device__ __forceinline__ void xcd_barrier_complete(unsigned* bar, unsigned x, unsigned& nloc, unsigned& nx) {
    const unsigned G = gridDim.x * gridDim.y * gridDim.z;
    unsigned sum, cnt, mine, sp = 0u;
    for (;;) {
        sum = 0u; cnt = 0u; mine = 0u;
#pragma unroll
        for (unsigned j = 0; j < 16; ++j) { const unsigned c = xb_ld(&bar[XB_XCNT(j)]); sum += c; cnt += (c > 0u) ? 1u : 0u; mine = (j == x) ? c : mine; }
        if (sum == G) break;
        __builtin_amdgcn_s_sleep(1);
        if ((++sp & 255u) == 0u) { if (xb_ld(&bar[XB_TMO])) break; if (sp > XB_SPIN_CAP) { atomicAdd(&bar[XB_TMO], 1u); break; } }
    }
    nloc = mine > 0u ? mine : 1u; nx = cnt > 0u ? cnt : 1u;
}
__device__ __forceinline__ void xcd_barrier(const XcdBarrier& b) {
    asm volatile("s_waitcnt vmcnt(0)" ::: "memory");
    __syncthreads();
    if (threadIdx.x == 0) {
        unsigned* bar = b.bar;
        __builtin_amdgcn_s_waitcnt(0);
        unsigned nloc = b.st[0], nx = b.st[1];
        if (nloc == 0u) { xcd_barrier_complete(bar, b.x, nloc, nx); b.st[0] = nloc; b.st[1] = nx; }
        const unsigned old = xb_add(&bar[XB_XSUB(b.x)], 1u);
        const unsigned gen = old / nloc;
        if (old + 1u == (gen + 1u) * nloc) {
            __builtin_amdgcn_fence(__ATOMIC_RELEASE, "agent");
            asm volatile("s_waitcnt vmcnt(0)" ::: "memory");
            const unsigned og = xb_add(&bar[XB_TOP], 1u);
            const unsigned tg = og / nx;
            if (og + 1u == (tg + 1u) * nx) xb_add(&bar[XB_TOPGEN], 1u);
            else XB_SPIN(xb_ld(&bar[XB_TOPGEN]) == tg, bar);
            __builtin_amdgcn_fence(__ATOMIC_ACQUIRE, "agent");
            xb_add(&bar[XB_XGEN(b.x)], 1u);
            asm volatile("s_waitcnt vmcnt(0)" ::: "memory");
        } else {
            XB_SPIN(xb_ld(&bar[XB_XGEN(b.x)]) == gen, bar);
            __builtin_amdgcn_fence(__ATOMIC_ACQUIRE, "agent");
            asm volatile("s_waitcnt vmcnt(0)" ::: "memory");
        }
    }
    __syncthreads();
}

using pg8::Unit;
struct EpiStore {
    static constexpr bool PERM = true;
    bf16* O0; bf16* O1; int tiles0, ld0, ld1; int rdiv = 0;
    __device__ __forceinline__ void operator()(f32x4 (&acc)[2][2][4][2], const Unit& u, int wr, int wc, int fr, int fq) const {
        const bool first = u.pn < tiles0; bf16* base = first ? O0 : O1; const int ld = first ? ld0 : ld1; const int ct = first ? u.pn : u.pn - tiles0;
        const int row0 = (rdiv > 1 ? u.pm / rdiv : u.pm) * 256 + wr * 64 + fr, col0 = ct * 256 + wc * 32 + 8 * fq;
#pragma unroll
        for (int ai = 0; ai < 2; ++ai)
#pragma unroll
            for (int m = 0; m < 4; ++m) { bf16* rowp = base + (size_t)(row0 + ai * 128 + m * 16) * ld + col0;
#pragma unroll
                for (int bj = 0; bj < 2; ++bj) { const f32x4 v0 = acc[ai][bj][m][0], v1 = acc[ai][bj][m][1]; v4u w;
                    w.x = pk2(v0[0], v0[1]); w.y = pk2(v0[2], v0[3]); w.z = pk2(v1[0], v1[1]); w.w = pk2(v1[2], v1[3]);
                    *(v4u*)(rowp + bj * 128) = w; } }
    }
};
__device__ __forceinline__ float softplus_f(float x) { const float ex = __expf(x); return x > 20.f ? x : (ex < 0.01f ? ex * (1.0f - ex * (0.5f - ex * 0.33333334f)) : __logf(1.0f + ex)); }
__device__ __forceinline__ void store_tile(const f32x4 (&acc)[2][2][4][2], bf16* base, int ld, int ct, int row0, int wc, int fq) {
    const int col0 = ct * 256 + wc * 32 + 8 * fq;
#pragma unroll
    for (int ai = 0; ai < 2; ++ai)
#pragma unroll
        for (int m = 0; m < 4; ++m) { bf16* rowp = base + (size_t)(row0 + ai * 128 + m * 16) * ld + col0;
#pragma unroll
            for (int bj = 0; bj < 2; ++bj) { const f32x4 v0 = acc[ai][bj][m][0], v1 = acc[ai][bj][m][1]; v4u w;
                w.x = pk2(v0[0], v0[1]); w.y = pk2(v0[2], v0[3]); w.z = pk2(v1[0], v1[1]); w.w = pk2(v1[2], v1[3]);
                *(v4u*)(rowp + bj * 128) = w; } }
}
struct EpiInA {
    static constexpr bool PERM = true;
    bf16 *XS, *BCRAW, *RQ, *RK, *RV; float *DT, *LA; const float* rope; const float* dt_bias; const float* a_log;
    __device__ __forceinline__ void operator()(f32x4 (&acc)[2][2][4][2], const Unit& u, int wr, int wc, int fr, int fq) const {
        const int t = u.pn, row0 = u.pm * 256 + wr * 64 + fr;
        if (t < 4) store_tile(acc, XS, 1024, t, row0, wc, fq);
        else if (t < 6) store_tile(acc, BCRAW, 512, t - 4, row0, wc, fq);
        else if (t >= 10 && t < 14) store_tile(acc, RV, 1024, t - 10, row0, wc, fq);
        else if (t < 10) {
            const bool isk = t >= 8; bf16* base = isk ? RK : RQ; const int hp = (isk ? t - 8 : t - 6) * 2;
            const int q = wc * 32 + 8 * fq, head = hp + (q >> 6), d0 = q & 63; const float sc = isk ? 0.08838834764831845f : 1.0f;
#pragma unroll
            for (int ai = 0; ai < 2; ++ai)
#pragma unroll
                for (int m = 0; m < 4; ++m) { const int row = row0 + ai * 128 + m * 16; const int pos = row % TT;
                    const f32x4* rp = (const f32x4*)(rope + ((size_t)pos * 64 + d0) * 2);
                    const f32x4 c0 = rp[0], c1 = rp[1], c2 = rp[2], c3 = rp[3];
                    const f32x4 a0 = acc[ai][0][m][0], a1 = acc[ai][0][m][1], b0 = acc[ai][1][m][0], b1 = acc[ai][1][m][1];
                    const f32x4 cs0 = {c0[0], c0[2], c1[0], c1[2]}, sn0 = {c0[1], c0[3], c1[1], c1[3]}, cs1 = {c2[0], c2[2], c3[0], c3[2]}, sn1 = {c2[1], c2[3], c3[1], c3[3]};
                    const f32x4 p0 = (a0 * cs0 - b0 * sn0) * sc, p1 = (a1 * cs1 - b1 * sn1) * sc, q0 = (a0 * sn0 + b0 * cs0) * sc, q1 = (a1 * sn1 + b1 * cs1) * sc;
                    bf16* rowp = base + (size_t)row * 512 + head * 128 + d0; v4u w;
                    w.x = pk2(p0[0], p0[1]); w.y = pk2(p0[2], p0[3]); w.z = pk2(p1[0], p1[1]); w.w = pk2(p1[2], p1[3]); *(v4u*)rowp = w;
                    w.x = pk2(q0[0], q0[1]); w.y = pk2(q0[2], q0[3]); w.z = pk2(q1[0], q1[1]); w.w = pk2(q1[2], q1[3]); *(v4u*)(rowp + 64) = w; }
        } else {
            if (wc == 0) {
                const int c0 = 8 * fq;
                const f32x4 bi0 = *(const f32x4*)(dt_bias + c0), bi1 = *(const f32x4*)(dt_bias + c0 + 4), al0 = *(const f32x4*)(a_log + c0), al1 = *(const f32x4*)(a_log + c0 + 4);
                f32x4 ae0, ae1;
#pragma unroll
                for (int j = 0; j < 4; ++j) { ae0[j] = -__expf(al0[j]); ae1[j] = -__expf(al1[j]); }
#pragma unroll
                for (int ai = 0; ai < 2; ++ai)
#pragma unroll
                    for (int m = 0; m < 4; ++m) { const int row = row0 + ai * 128 + m * 16; const f32x4 x0 = acc[ai][0][m][0] + bi0, x1 = acc[ai][0][m][1] + bi1; f32x4 d0v, d1v;
#pragma unroll
                        for (int j = 0; j < 4; ++j) { d0v[j] = softplus_f(x0[j]); d1v[j] = softplus_f(x1[j]); }
                        f32x4* pd = (f32x4*)(DT + (size_t)row * 32 + c0); f32x4* pl = (f32x4*)(LA + (size_t)row * 32 + c0);
                        pd[0] = d0v; pd[1] = d1v; pl[0] = d0v * ae0; pl[1] = d1v * ae1; }
            }
        }
    }
};
struct TailMeet { float* part; unsigned* tkt; volatile LAS unsigned* flag; };
__device__ __forceinline__ bool tail_meet(const TailMeet& tm, f32x4 (&acc)[2][2][4][2], const Unit& u) {
    const int tid = threadIdx.x;
    float* mine = tm.part + ((size_t)u.tq * u.nsl + u.sl) * 65536 + (size_t)tid * 4;
#pragma unroll
    for (int ai = 0; ai < 2; ++ai)
#pragma unroll
        for (int bj = 0; bj < 2; ++bj)
#pragma unroll
            for (int m = 0; m < 4; ++m)
#pragma unroll
                for (int n = 0; n < 2; ++n) { float* q = mine + (size_t)(((ai * 2 + bj) * 4 + m) * 2 + n) * 2048; const f32x4 v = acc[ai][bj][m][n];
                    asm volatile("global_store_dwordx4 %0, %1, off sc1" :: "v"(q), "v"(v) : "memory"); }
    asm volatile("s_waitcnt vmcnt(0)" ::: "memory");
    __syncthreads();
    if (tid == 0) tm.flag[0] = __hip_atomic_fetch_add(tm.tkt + 64 * u.tq, 1u, __ATOMIC_RELAXED, __HIP_MEMORY_SCOPE_AGENT);
    __syncthreads();
    const unsigned t = tm.flag[0];
    if (t != (unsigned)(u.nsl - 1)) return false;
    __builtin_amdgcn_fence(__ATOMIC_ACQUIRE, "agent");
    asm volatile("s_waitcnt vmcnt(0)" ::: "memory");
#pragma unroll
    for (int ai = 0; ai < 2; ++ai)
#pragma unroll
        for (int bj = 0; bj < 2; ++bj)
#pragma unroll
            for (int m = 0; m < 4; ++m)
#pragma unroll
                for (int n = 0; n < 2; ++n) acc[ai][bj][m][n] = (f32x4){0.f, 0.f, 0.f, 0.f};
    for (int s = 0; s < u.nsl; ++s) { const float* src = tm.part + ((size_t)u.tq * u.nsl + s) * 65536 + (size_t)tid * 4;
#pragma unroll
        for (int ai = 0; ai < 2; ++ai)
#pragma unroll
            for (int bj = 0; bj < 2; ++bj)
#pragma unroll
                for (int m = 0; m < 4; ++m)
#pragma unroll
                    for (int n = 0; n < 2; ++n) acc[ai][bj][m][n] += *(const f32x4*)(src + (size_t)(((ai * 2 + bj) * 4 + m) * 2 + n) * 2048); }
    return true;
}
template <bool COMB> struct EpiRes {
    static constexpr bool PERM = false;
    const float* base_lat; const float* base_ctx; float* out_lat; float* out_ctx; const float* gate; TailMeet tm;
    __device__ __forceinline__ void operator()(f32x4 (&acc)[2][2][4][2], const Unit& u, int wr, int wc, int fr, int fq) const {
        const float* bp; float* op; const float* gp;
        if (COMB) { const int b = u.pm / PPB, pt = u.pm % PPB;
            if (pt == 0) { bp = base_ctx + (size_t)b * 256 * DM; op = out_ctx + (size_t)b * 256 * DM; gp = gate + 4 * 6144; }
            else { const size_t r = (size_t)b * SEQ + (size_t)(pt - 1) * 256; bp = base_lat + r * DM; op = out_lat + r * DM; gp = gate + b * 6144; }
        } else { const int b = u.pm / 32; bp = base_lat + (size_t)u.pm * 256 * DM; op = out_lat + (size_t)u.pm * 256 * DM; gp = gate + b * 6144; }
        const int col0 = u.pn * 256 + wc * 32 + 4 * fq;
        f32x4 gv[2][2];
#pragma unroll
        for (int bj = 0; bj < 2; ++bj)
#pragma unroll
            for (int n = 0; n < 2; ++n) gv[bj][n] = *(const f32x4*)(gp + col0 + bj * 128 + n * 16);
        if (u.split) { if (!tail_meet(tm, acc, u)) return; }
#pragma unroll
        for (int ai = 0; ai < 2; ++ai)
#pragma unroll
            for (int m = 0; m < 4; ++m) { const size_t off = (size_t)(ai * 128 + wr * 64 + m * 16 + fr) * DM + col0;
#pragma unroll
                for (int bj = 0; bj < 2; ++bj)
#pragma unroll
                    for (int n = 0; n < 2; ++n) { const f32x4 bs = *(const f32x4*)(bp + off + bj * 128 + n * 16);
                        *(f32x4*)(op + off + bj * 128 + n * 16) = bs + gv[bj][n] * acc[ai][bj][m][n]; } }
    }
};
template <bool COMB> struct EpiResB {
    static constexpr bool PERM = true;
    const float* base_lat; bf16* xb; float* ctx; const float* gate;
    __device__ __forceinline__ void operator()(f32x4 (&acc)[2][2][4][2], const Unit& u, int wr, int wc, int fr, int fq) const {
        int b; bool isctx = false; size_t r0;
        if (COMB) { b = u.pm / PPB; const int pt = u.pm % PPB; if (pt == 0) { isctx = true; r0 = (size_t)b * 256; } else r0 = (size_t)b * SEQ + (size_t)(pt - 1) * 256; }
        else { b = u.pm / 32; r0 = (size_t)u.pm * 256; }
        const float* gp = gate + (isctx ? 4 : b) * 6144;
        const int col0 = u.pn * 256 + wc * 32 + 8 * fq;
        f32x4 gv[2][2];
#pragma unroll
        for (int bj = 0; bj < 2; ++bj)
#pragma unroll
            for (int n = 0; n < 2; ++n) gv[bj][n] = *(const f32x4*)(gp + col0 + bj * 128 + n * 4);
        if (COMB && isctx) {
#pragma unroll
            for (int ai = 0; ai < 2; ++ai)
#pragma unroll
                for (int m = 0; m < 4; ++m) { float* rp = ctx + (r0 + (size_t)(ai * 128 + wr * 64 + m * 16 + fr)) * DM + col0;
#pragma unroll
                    for (int bj = 0; bj < 2; ++bj) { const f32x4 b0 = *(const f32x4*)(rp + bj * 128), b1 = *(const f32x4*)(rp + bj * 128 + 4);
                        *(f32x4*)(rp + bj * 128) = b0 + gv[bj][0] * acc[ai][bj][m][0]; *(f32x4*)(rp + bj * 128 + 4) = b1 + gv[bj][1] * acc[ai][bj][m][1]; } }
        } else if (base_lat != nullptr) {
#pragma unroll
            for (int ai = 0; ai < 2; ++ai)
#pragma unroll
                for (int m = 0; m < 4; ++m) { const size_t off = (r0 + (size_t)(ai * 128 + wr * 64 + m * 16 + fr)) * DM + col0;
#pragma unroll
                    for (int bj = 0; bj < 2; ++bj) { const f32x4 b0 = *(const f32x4*)(base_lat + off + bj * 128), b1 = *(const f32x4*)(base_lat + off + bj * 128 + 4);
                        const f32x4 y0 = b0 + gv[bj][0] * acc[ai][bj][m][0], y1 = b1 + gv[bj][1] * acc[ai][bj][m][1]; v4u w;
                        w.x = pk2(y0[0], y0[1]); w.y = pk2(y0[2], y0[3]); w.z = pk2(y1[0], y1[1]); w.w = pk2(y1[2], y1[3]); *(v4u*)(xb + off + bj * 128) = w; } }
        } else {
#pragma unroll
            for (int ai = 0; ai < 2; ++ai)
#pragma unroll
                for (int m = 0; m < 4; ++m) { bf16* rp = xb + (r0 + (size_t)(ai * 128 + wr * 64 + m * 16 + fr)) * DM + col0;
#pragma unroll
                    for (int bj = 0; bj < 2; ++bj) { const v4u x = *(const v4u*)(rp + bj * 128); const f32x4 a0 = gv[bj][0] * acc[ai][bj][m][0], a1 = gv[bj][1] * acc[ai][bj][m][1]; v4u w;
                        w.x = pk2(bflo(x.x) + a0[0], bfhi(x.x) + a0[1]); w.y = pk2(bflo(x.y) + a0[2], bfhi(x.y) + a0[3]);
                        w.z = pk2(bflo(x.z) + a1[0], bfhi(x.z) + a1[1]); w.w = pk2(bflo(x.w) + a1[2], bfhi(x.w) + a1[3]); *(v4u*)(rp + bj * 128) = w; } }
        }
    }
};
struct EpiCtxPart {
    static constexpr bool PERM = false;
    float* part; const float* gate;
    __device__ __forceinline__ void operator()(f32x4 (&acc)[2][2][4][2], const Unit& u, int wr, int wc, int fr, int fq) const {
        const int b = u.pm / PPB; const float* gp = gate + 4 * 6144; const int col0 = u.pn * 256 + wc * 32 + 4 * fq;
        float* op = part + ((size_t)u.sl * (NB * LCTX) + (size_t)b * 256) * DM;
        f32x4 gv[2][2];
#pragma unroll
        for (int bj = 0; bj < 2; ++bj)
#pragma unroll
            for (int n = 0; n < 2; ++n) gv[bj][n] = *(const f32x4*)(gp + col0 + bj * 128 + n * 16);
#pragma unroll
        for (int ai = 0; ai < 2; ++ai)
#pragma unroll
            for (int m = 0; m < 4; ++m) { const size_t off = (size_t)(ai * 128 + wr * 64 + m * 16 + fr) * DM + col0;
#pragma unroll
                for (int bj = 0; bj < 2; ++bj)
#pragma unroll
                    for (int n = 0; n < 2; ++n) *(f32x4*)(op + off + bj * 128 + n * 16) = gv[bj][n] * acc[ai][bj][m][n]; }
    }
};
struct EpiSwiglu {
    static constexpr bool PERM = true;
    bf16* O; int ldc; int nN; int rshift;
    __device__ __forceinline__ void operator()(f32x4 (&acc)[2][2][4][2], const Unit& u, int wr, int wc, int fr, int fq) const {
        const int ct = nN ? u.pn % nN : u.pn; const int rt = u.pm < 128 ? u.pm : u.pm + rshift; const int row0 = rt * 256 + wr * 64 + fr, col0 = ct * 128 + wc * 32 + 8 * fq;
#pragma unroll
        for (int ai = 0; ai < 2; ++ai)
#pragma unroll
            for (int m = 0; m < 4; ++m) { const f32x4 g0 = acc[ai][0][m][0], g1 = acc[ai][0][m][1], u0 = acc[ai][1][m][0], u1 = acc[ai][1][m][1]; v4u w;
                w.x = pk2(silu_f(g0[0]) * u0[0], silu_f(g0[1]) * u0[1]); w.y = pk2(silu_f(g0[2]) * u0[2], silu_f(g0[3]) * u0[3]);
                w.z = pk2(silu_f(g1[0]) * u1[0], silu_f(g1[1]) * u1[1]); w.w = pk2(silu_f(g1[2]) * u1[2], silu_f(g1[3]) * u1[3]);
                *(v4u*)(O + (size_t)(row0 + ai * 128 + m * 16) * ldc + col0) = w; }
    }
};
struct EpiQK {
    static constexpr bool PERM = false;
    bf16 *Q, *K; const float *qg, *kg; const float *ropeR, *ropeC;
    __device__ __forceinline__ void operator()(f32x4 (&acc)[2][2][4][2], const Unit& u, int wr, int wc, int fr, int fq) const {
        const bool isk = u.pn >= 4; const int sub = (u.pn & 3) * 4 + wc; bf16* base = isk ? K : Q; const float* gn = isk ? kg : qg;
        const float osc = isk ? 1.0f : 0.125f * LOG2E;
        f32x4 g[2][2];
#pragma unroll
        for (int bj = 0; bj < 2; ++bj)
#pragma unroll
            for (int n = 0; n < 2; ++n) g[bj][n] = *(const f32x4*)(gn + 32 * bj + 16 * n + 4 * fq);
#pragma unroll
        for (int ai = 0; ai < 2; ++ai)
#pragma unroll
            for (int m = 0; m < 4; ++m) { const int row = u.pm * 256 + ai * 128 + wr * 64 + m * 16 + fr; const int t = row % TT;
                float ss = 0.f;
#pragma unroll
                for (int bj = 0; bj < 2; ++bj)
#pragma unroll
                    for (int n = 0; n < 2; ++n) { const f32x4 x = acc[ai][bj][m][n]; ss += (x[0] * x[0] + x[1] * x[1]) + (x[2] * x[2] + x[3] * x[3]); }
                ss += __shfl_xor(ss, 16); ss += __shfl_xor(ss, 32);
                const float rstd = __builtin_amdgcn_rsqf(ss * (1.0f / 64.0f) + NORM_EPS) ;
                f32x4 y[2][2];
#pragma unroll
                for (int bj = 0; bj < 2; ++bj)
#pragma unroll
                    for (int n = 0; n < 2; ++n) y[bj][n] = acc[ai][bj][m][n] * rstd * g[bj][n];
                if (t >= LCTX) { const int l = t - LCTX, gr = l >> 6, gc = l & 63;
                    const f32x4* pr = (const f32x4*)(ropeR + ((size_t)gr * 16 + 4 * fq) * 2); const f32x4* pc = (const f32x4*)(ropeC + ((size_t)gc * 16 + 4 * fq) * 2);
                    const f32x4 r0 = pr[0], r1 = pr[1], c0 = pc[0], c1 = pc[1];
                    const f32x4 csr = {r0[0], r0[2], r1[0], r1[2]}, snr = {r0[1], r0[3], r1[1], r1[3]}, csc = {c0[0], c0[2], c1[0], c1[2]}, snc = {c0[1], c0[3], c1[1], c1[3]};
                    const f32x4 a = y[0][0], b = y[0][1]; y[0][0] = a * csr - b * snr; y[0][1] = a * snr + b * csr;
                    const f32x4 c = y[1][0], d = y[1][1]; y[1][0] = c * csc - d * snc; y[1][1] = c * snc + d * csc; }
                if (isk || t >= LCTX) { bf16* rowp = base + (size_t)row * 1024 + sub * 64 + 8 * fq;
#pragma unroll
                    for (int bj = 0; bj < 2; ++bj) { const f32x4 o0 = y[bj][0] * osc, o1 = y[bj][1] * osc; v4u w; w.x = pk2(o0[0], o0[1]); w.y = pk2(o0[2], o0[3]); w.z = pk2(o1[0], o1[1]); w.w = pk2(o1[2], o1[3]);
                        *(v4u*)(rowp + 32 * bj) = w; } } }
    }
};
struct EpiMoeDownScratch {
    static constexpr bool PERM = false;
    float* scr; const float* gate; const int* slot_tok; const float* slot_w;
    __device__ __forceinline__ void operator()(f32x4 (&acc)[2][2][4][2], const Unit& u, int wr, int wc, int fr, int fq) const {
        const int col0 = (u.pn & 3) * 256 + wc * 32 + 4 * fq;
#pragma unroll
        for (int ai = 0; ai < 2; ++ai)
#pragma unroll
            for (int m = 0; m < 4; ++m) { const int slot = u.pm * 256 + ai * 128 + wr * 64 + m * 16 + fr; const int tok = slot_tok[slot];
                if (tok >= 0) { const float w = slot_w[slot]; const float* gp = gate + (tok >> 13) * 6144 + col0; float* op = scr + (size_t)(slot - 128 * 256) * DM + col0;
#pragma unroll
                    for (int bj = 0; bj < 2; ++bj)
#pragma unroll
                        for (int n = 0; n < 2; ++n) { const f32x4 gv = *(const f32x4*)(gp + bj * 128 + n * 16); *(f32x4*)(op + bj * 128 + n * 16) = gv * w * acc[ai][bj][m][n]; } } }
    }
};
struct EpiMoeDown {
    static constexpr bool PERM = false;
    float* out; const float* gate; const int* slot_tok; const float* slot_w; TailMeet tm;
    __device__ __forceinline__ void operator()(f32x4 (&acc)[2][2][4][2], const Unit& u, int wr, int wc, int fr, int fq) const {
        if (u.split) { if (!tail_meet(tm, acc, u)) return; }
        const int col0 = (u.pn & 3) * 256 + wc * 32 + 4 * fq;
#pragma unroll
        for (int ai = 0; ai < 2; ++ai)
#pragma unroll
            for (int m = 0; m < 4; ++m) { const int slot = u.pm * 256 + ai * 128 + wr * 64 + m * 16 + fr; const int tok = slot_tok[slot];
                if (tok >= 0) { const float w = slot_w[slot]; const float* gp = gate + (tok >> 13) * 6144 + col0; float* op = out + (size_t)tok * DM + col0;
#pragma unroll
                    for (int bj = 0; bj < 2; ++bj)
#pragma unroll
                        for (int n = 0; n < 2; ++n) { const f32x4 gv = *(const f32x4*)(gp + bj * 128 + n * 16); const f32x4 bs = *(const f32x4*)(op + bj * 128 + n * 16);
                            *(f32x4*)(op + bj * 128 + n * 16) = bs + gv * w * acc[ai][bj][m][n]; } } }
    }
};
struct EpiMoeDownB {
    static constexpr bool PERM = true;
    bf16* xb; float* outf; const float* gate; const int* slot_tok; const float* slot_w; int fin;
    __device__ __forceinline__ void operator()(f32x4 (&acc)[2][2][4][2], const Unit& u, int wr, int wc, int fr, int fq) const {
        const int col0 = (u.pn & 3) * 256 + wc * 32 + 8 * fq;
#pragma unroll
        for (int ai = 0; ai < 2; ++ai)
#pragma unroll
            for (int m = 0; m < 4; ++m) { const int slot = u.pm * 256 + ai * 128 + wr * 64 + m * 16 + fr; const int tok = slot_tok[slot];
                if (tok >= 0) { const float w = slot_w[slot]; const float* gp = gate + (tok >> 13) * 6144 + col0; bf16* rp = xb + (size_t)tok * DM + col0; const bool tof = fin && tok < MLAT / 2;
#pragma unroll
                    for (int bj = 0; bj < 2; ++bj) { const f32x4 g0 = *(const f32x4*)(gp + bj * 128), g1 = *(const f32x4*)(gp + bj * 128 + 4); const v4u x = *(const v4u*)(rp + bj * 128);
                        const f32x4 a0 = g0 * w * acc[ai][bj][m][0], a1 = g1 * w * acc[ai][bj][m][1];
                        const f32x4 y0 = (f32x4){bflo(x.x) + a0[0], bfhi(x.x) + a0[1], bflo(x.y) + a0[2], bfhi(x.y) + a0[3]}, y1 = (f32x4){bflo(x.z) + a1[0], bfhi(x.z) + a1[1], bflo(x.w) + a1[2], bfhi(x.w) + a1[3]};
                        if (tof) { float* fp = outf + (size_t)tok * DM + col0 + bj * 128; *(f32x4*)(fp) = y0; *(f32x4*)(fp + 4) = y1; }
                        else { v4u o; o.x = pk2(y0[0], y0[1]); o.y = pk2(y0[2], y0[3]); o.z = pk2(y1[0], y1[1]); o.w = pk2(y1[2], y1[3]); *(v4u*)(rp + bj * 128) = o; } } } }
    }
};

enum InIdx { I_X = 0, I_C, I_CTX, I_CCTX, I_EWMOD, I_EBMOD, I_ENORM1, I_ENORM2, I_EWIN, I_ECONVW, I_ECONVB, I_EDTB, I_EALOG, I_ED, I_ESSDN, I_ERETD, I_EWOUT,
             I_EFG, I_EFU, I_EFD, I_OWMOD, I_OBMOD, I_ONORM1, I_ONORM2, I_OWIN, I_OQN, I_OKN, I_OLAM, I_OSUBLN, I_OWOUT, I_OROUTER, I_OEG, I_OEU, I_OED, N_IN };
#if defined(__HIP_DEVICE_COMPILE__)
#define ARG_AS GAS
#else
#define ARG_AS
#endif
struct Args { const ARG_AS float* in[N_IN]; ARG_AS float* out; ARG_AS unsigned char* ws; int ph_lo, ph_hi, zgate, pad; };
__device__ __forceinline__ ARG_AS unsigned char* launder_ptr(ARG_AS unsigned char* p) { asm volatile("" : "+s"(p)); return p; }

__device__ __forceinline__ unsigned pkc(float lo, float hi) {
    typedef __bf16 bf16x2_t __attribute__((ext_vector_type(2)));
    f32x2 v = {lo, hi}; bf16x2_t b = __builtin_convertvector(v, bf16x2_t); return __builtin_bit_cast(unsigned, b);
}
#define MFMA16(a, b, c) __builtin_amdgcn_mfma_f32_16x16x32_bf16(__builtin_bit_cast(bf16x8, a), __builtin_bit_cast(bf16x8, b), c, 0, 0, 0)
#define MFMA32(a, b, c) __builtin_amdgcn_mfma_f32_32x32x16_bf16(__builtin_bit_cast(bf16x8, a), __builtin_bit_cast(bf16x8, b), c, 0, 0, 0)

__device__ __forceinline__ void transpose_item(const float* W, int ldw, int col0, int k0, bf16* dst, size_t drow0, int K, LAS float* scr, int lane) {
    float t[32];
#pragma unroll
    for (int i = 0; i < 32; ++i) { const int kk = 2 * i + (lane >> 5); t[i] = W[(size_t)(k0 + kk) * ldw + col0 + (lane & 31)]; }
#pragma unroll
    for (int i = 0; i < 32; ++i) { const int kk = 2 * i + (lane >> 5); scr[kk * 33 + (lane & 31)] = t[i]; }
    asm volatile("s_waitcnt lgkmcnt(0)" ::: "memory");
    const int c = lane & 7;
#pragma unroll
    for (int j = 0; j < 4; ++j) { const int n = (lane >> 3) + 8 * j; const LAS float* s = scr + (8 * c) * 33 + n;
        v4u o; o.x = pk2(s[0 * 33], s[1 * 33]); o.y = pk2(s[2 * 33], s[3 * 33]); o.z = pk2(s[4 * 33], s[5 * 33]); o.w = pk2(s[6 * 33], s[7 * 33]);
        *(v4u*)(dst + (drow0 + n) * K + k0 + 8 * c) = o; }
    asm volatile("s_waitcnt lgkmcnt(0)" ::: "memory");
}
struct WJob { int nrg, nkb; };
__device__ __forceinline__ void small_weight_item(const Args& a, int mat, int rg, int kb, LAS float* scr, int lane) {
    unsigned char* ws = launder_ptr(a.ws); const int row = rg * 32;
    switch (mat) {
    case 0: { const float* W = a.in[I_EWIN]; int col; if (row < 1536) col = 1024 + row;
              else if (row < 2560) { const bool isk = row >= 2048; const int rr = row - (isk ? 2048 : 1536), tq = rr >> 8, p = rr & 255, half = p >> 7, q = p & 127; col = (isk ? 3104 : 2592) + (2 * tq + (q >> 6)) * 128 + (q & 63) + 64 * half; }
              else if (row < 3584) col = 3616 + (row - 2560); else col = 2560 + (row - 3584);
              transpose_item(W, EVEN_IN, col, kb * 64, (bf16*)(ws + WS_WINA), row, 1024, scr, lane); } break;
    case 1: { const int col = row < 1024 ? row : 4640 + (row - 1024); transpose_item(a.in[I_EWIN], EVEN_IN, col, kb * 64, (bf16*)(ws + WS_WINB), row, 1024, scr, lane); } break;
    case 2: transpose_item(a.in[I_EWOUT], 1024, row, kb * 64, (bf16*)(ws + WS_WOUT0), row, 2048, scr, lane); break;
    case 3: { const int tile = row >> 8, p = row & 255; const float* W = p < 128 ? a.in[I_EFG] : a.in[I_EFU]; transpose_item(W, FFD, tile * 128 + (p & 127), kb * 64, (bf16*)(ws + WS_WGU0), row, 1024, scr, lane); } break;
    case 4: transpose_item(a.in[I_EFD], 1024, row, kb * 64, (bf16*)(ws + WS_WDN0), row, FFD, scr, lane); break;
    case 5: { const int tile = row >> 8, p = row & 255, bj = p >> 7, wc = (p >> 5) & 3; const int col = (tile >= 4 ? 1024 : 0) + ((tile & 3) * 4 + wc) * 64 + 32 * bj;
              transpose_item(a.in[I_OWIN], 3072, col, kb * 64, (bf16*)(ws + WS_WQK), row, 1024, scr, lane); } break;
    case 6: transpose_item(a.in[I_OWIN], 3072, 2048 + row, kb * 64, (bf16*)(ws + WS_WV), row, 1024, scr, lane); break;
    default: transpose_item(a.in[I_OWOUT], 1024, row, kb * 64, (bf16*)(ws + WS_WO1), row, 1024, scr, lane); break;
    }
}
__device__ __forceinline__ void p0_prologue(const Args& a, LAS unsigned char* lds, int tid, int lane, int wave) {
    unsigned char* ws = launder_ptr(a.ws);
    const int G = gridDim.x, gw = blockIdx.x * NWAVES + wave, NGW = G * NWAVES;
    {
        LAS float* sc = (LAS float*)(lds + 131072 - 20480 - 10240);
        LAS float* red = (LAS float*)(lds + 131072 - 10240);
        { float cv[5 * 1024 / NTHR];
#pragma unroll
          for (int k = 0; k < 5 * 1024 / NTHR; ++k) { const int i = tid + k * NTHR; cv[k] = i < 4096 ? a.in[I_C][i] : a.in[I_CCTX][i - 4096]; }
#pragma unroll
          for (int k = 0; k < 5 * 1024 / NTHR; ++k) sc[tid + k * NTHR] = silu_f(cv[k]); }
        __syncthreads();
        for (int it = blockIdx.x; it < 2 * 96; it += G) {
            const int layer = it / 96, col0 = (it % 96) * 64; const float* W = layer ? a.in[I_OWMOD] : a.in[I_EWMOD]; const float* bm = layer ? a.in[I_OBMOD] : a.in[I_EBMOD];
            float acc[5] = {0.f, 0.f, 0.f, 0.f, 0.f};
#pragma unroll 8
            for (int k = wave * 128; k < wave * 128 + 128; ++k) { const float wv = W[(size_t)k * 6144 + col0 + lane];
#pragma unroll
                for (int c = 0; c < 5; ++c) acc[c] += sc[c * 1024 + k] * wv; }
#pragma unroll
            for (int c = 0; c < 5; ++c) red[(wave * 5 + c) * 64 + lane] = acc[c];
            __syncthreads();
            if (tid < 320) { const int c = tid >> 6, col = tid & 63; float s = bm[col0 + col];
#pragma unroll
                for (int w = 0; w < 8; ++w) s += red[(w * 5 + c) * 64 + col];
                ((float*)(ws + WS_MOD))[(size_t)(layer * 5 + c) * 6144 + col0 + col] = s; }
            __syncthreads();
        }
    }
    { float* sm = (float*)(ws + WS_CTL + 819200);
      for (int i = blockIdx.x * NTHR + tid; i < 196 * 64; i += G * NTHR) { const int kind = i >> 6, f = i & 63; const double w = pow(10000.0, -(double)f / 64.0);
          const double ang = (double)(kind < 132 ? 64 * kind : kind - 132) * w; sm[2 * i] = (float)cos(ang); sm[2 * i + 1] = (float)sin(ang); } }
}
constexpr int DENSE_W_EARLY = 113 * 16 + 64 * 16, DENSE_W_TOTAL = DENSE_W_EARLY + 32 * 32 + 176 * 16 + 32 * 44 + 64 * 16 + 32 * 16 + 32 * 16;
__device__ __forceinline__ void dense_weight_convert(const Args& a, LAS unsigned char* lds, int lane, int wave, int lo, int hi, int w, int nw) {
    if (w < 0) return;
    LAS float* scr = (LAS float*)(lds + wave * 8704);
    const int nrg[8] = {113, 64, 32, 176, 32, 64, 32, 32}, nkb[8] = {16, 16, 32, 16, 44, 16, 16, 16};
    for (int it = lo + w; it < hi; it += nw) { int r = it, m = 0;
#pragma unroll
        for (int q = 0; q < 7; ++q) { if (m == q && r >= nrg[q] * nkb[q]) { r -= nrg[q] * nkb[q]; m = q + 1; } }
        int nk = 16; if (m == 2) nk = 32; else if (m == 4) nk = 44;
        small_weight_item(a, m, r / nk, r % nk, scr, lane); }
}
__device__ __forceinline__ void p0_weights(const Args& a, LAS unsigned char* lds, int tid, int lane, int wave) {
    unsigned char* ws = launder_ptr(a.ws);
    const int G = gridDim.x, gw = blockIdx.x * NWAVES + wave, NGW = G * NWAVES;
    dense_weight_convert(a, lds, lane, wave, 0, G == 256 ? DENSE_W_EARLY : DENSE_W_TOTAL, gw, NGW);
    {
        const int gt = blockIdx.x * NTHR + tid, NT = G * NTHR;
        float* rr = (float*)(ws + WS_ROPERET);
        { const f32x2* sm = (const f32x2*)(ws + WS_CTL + 819200);
          for (int i = gt; i < TT * 64; i += NT) { const int pos = i >> 6, f = i & 63; const f32x2 pa = sm[(pos >> 6) * 64 + f], pb = sm[(132 + (pos & 63)) * 64 + f];
              *(f32x2*)(rr + 2 * i) = (f32x2){pa[0] * pb[0] - pa[1] * pb[1], pa[1] * pb[0] + pa[0] * pb[1]}; } }
        float* r2 = (float*)(ws + WS_ROPER); float* c2 = (float*)(ws + WS_ROPEC);
        for (int i = gt; i < 128 * 16; i += NT) { const int pos = i >> 4, f = i & 15; const double ang = (double)pos * pow(10000.0, -(double)f / 16.0); r2[2 * i] = (float)cos(ang); r2[2 * i + 1] = (float)sin(ang);
            if (pos < 64) { c2[2 * i] = (float)cos(ang); c2[2 * i + 1] = (float)sin(ang); } }
        if (gt == 0) { const float* lm = a.in[I_OLAM]; float s1 = 0.f, s2 = 0.f; for (int i = 0; i < 64; ++i) { s1 += lm[i] * lm[64 + i]; s2 += lm[128 + i] * lm[192 + i]; }
            float gq = 0.f, gk = 0.f; for (int i = 0; i < 64; ++i) { gq = fmaxf(gq, fabsf(a.in[I_OQN][i])); gk = fmaxf(gk, fabsf(a.in[I_OKN][i])); }
            float* sc = (float*)(ws + WS_SCAL); sc[0] = expf(s1) - expf(s2) + LAM_INIT; sc[1] = 8.0f * gq * gk * LOG2E * 1.01f + 0.5f; }
    }
}
constexpr int MOE_CVT_ITEMS = NEXP * 224 * 16 + NEXP * 32 * 56;
struct TpItem { const float* W; int ldw, col0, k0; bf16* dst; size_t drow0; int K; };
__device__ __forceinline__ void tp_load(const TpItem& q, int lane, float (&t)[32]) {
#pragma unroll
    for (int i = 0; i < 32; ++i) { const int kk = 2 * i + (lane >> 5); t[i] = q.W[(size_t)(q.k0 + kk) * q.ldw + q.col0 + (lane & 31)]; }
}
__device__ __forceinline__ void tp_store(const TpItem& q, LAS float* scr, int lane, const float (&t)[32]) {
#pragma unroll
    for (int i = 0; i < 32; ++i) { const int kk = 2 * i + (lane >> 5); scr[kk * 33 + (lane & 31)] = t[i]; }
    asm volatile("s_waitcnt lgkmcnt(0)" ::: "memory");
    const int c = lane & 7;
#pragma unroll
    for (int j = 0; j < 4; ++j) { const int n = (lane >> 3) + 8 * j; const LAS float* s = scr + (8 * c) * 33 + n;
        v4u o; o.x = pk2(s[0 * 33], s[1 * 33]); o.y = pk2(s[2 * 33], s[3 * 33]); o.z = pk2(s[4 * 33], s[5 * 33]); o.w = pk2(s[6 * 33], s[7 * 33]);
        *(v4u*)(q.dst + (q.drow0 + n) * q.K + q.k0 + 8 * c) = o; }
    asm volatile("s_waitcnt lgkmcnt(0)" ::: "memory");
}
__device__ __forceinline__ TpItem moe_item(const Args& a, unsigned char* ws, int it) {
    constexpr int IGU = NEXP * 224 * 16; TpItem q;
    if (it < IGU) { const int e = it / (224 * 16), r = it % (224 * 16), rg = r / 16, kb = r % 16, row = rg * 32, tile = row >> 8, p = row & 255;
        q.W = (p < 128 ? a.in[I_OEG] : a.in[I_OEU]) + (size_t)e * 1024 * FFE; q.ldw = FFE; q.col0 = tile * 128 + (p & 127); q.k0 = kb * 64; q.dst = (bf16*)(ws + R_MOEGU) + (size_t)e * 7168 * 1024; q.drow0 = row; q.K = 1024; }
    else { const int x = it - IGU, e = x / (32 * 56), r = x % (32 * 56), rg = r / 56, kb = r % 56;
        q.W = a.in[I_OED] + (size_t)e * FFE * 1024; q.ldw = 1024; q.col0 = rg * 32; q.k0 = kb * 64; q.dst = (bf16*)(ws + R_MOEDN) + (size_t)e * 1024 * FFE; q.drow0 = rg * 32; q.K = FFE; }
    return q;
}
__device__ __forceinline__ void moe_weight_convert(const Args& a, LAS unsigned char* lds, int lane, int wave, int lo, int hi, int w, int nw) {
    unsigned char* ws = launder_ptr(a.ws); LAS float* scr = (LAS float*)(lds + wave * 8704);
    if (w < 0) return;
    int it = lo + w; if (it >= hi) return;
    float ta[32], tb[32]; TpItem qa = moe_item(a, ws, it), qb = qa;
    tp_load(qa, lane, ta);
    for (;;) {
        const int itb = it + nw; const bool hb = itb < hi; if (hb) { qb = moe_item(a, ws, itb); tp_load(qb, lane, tb); }
        tp_store(qa, scr, lane, ta);
        if (!hb) break;
        const int ita = itb + nw; const bool ha = ita < hi; if (ha) { qa = moe_item(a, ws, ita); tp_load(qa, lane, ta); }
        tp_store(qb, scr, lane, tb);
        if (!ha) break;
        it = ita;
    }
}

template <bool COMB> __device__ __forceinline__ void mod_rows(const float* src_lat, const float* src_ctx, bf16* H, const float* gain, const float* modL, int sh_off, int sc_off, int lane, int wave, float* ctx_copy = nullptr) {
    const int gw = blockIdx.x * NWAVES + wave, NGW = gridDim.x * NWAVES; const int nrows = COMB ? MROWS : MLAT;
    f32x4 gv[4];
#pragma unroll
    for (int j = 0; j < 4; ++j) gv[j] = *(const f32x4*)(gain + 4 * lane + 256 * j);
    for (int row = gw; row < nrows; row += NGW) {
        const float* src; int cond; float* cpy = nullptr;
        if (COMB) { const int b = row / TT, t = row % TT; if (t < LCTX) { src = src_ctx + (size_t)(b * LCTX + t) * DM; cond = 4; if (ctx_copy) cpy = ctx_copy + (size_t)(b * LCTX + t) * DM; } else { src = src_lat + (size_t)(b * SEQ + t - LCTX) * DM; cond = b; } }
        else { src = src_lat + (size_t)row * DM; cond = row >> 13; }
        const float* mp = modL + cond * 6144;
        f32x4 v[4]; float ss = 0.f;
#pragma unroll
        for (int j = 0; j < 4; ++j) { v[j] = *(const f32x4*)(src + 4 * lane + 256 * j); ss += (v[j][0] * v[j][0] + v[j][1] * v[j][1]) + (v[j][2] * v[j][2] + v[j][3] * v[j][3]); }
        if (cpy) {
#pragma unroll
            for (int j = 0; j < 4; ++j) *(f32x4*)(cpy + 4 * lane + 256 * j) = v[j]; }
        const float rstd = 1.0f / sqrtf(wave_sum(ss) * (1.0f / DM) + NORM_EPS);
#pragma unroll
        for (int j = 0; j < 4; ++j) { const f32x4 sh = *(const f32x4*)(mp + sh_off + 4 * lane + 256 * j), sc = *(const f32x4*)(mp + sc_off + 4 * lane + 256 * j);
            const f32x4 y = v[j] * rstd * gv[j] * (sc + 1.0f) + sh; v2u w; w.x = pk2(y[0], y[1]); w.y = pk2(y[2], y[3]);
            *(v2u*)(H + (size_t)row * DM + 4 * lane + 256 * j) = w; }
    }
}

template <int SEL> __device__ __forceinline__ void mod_rows_part(const bf16* src_lat, const float* src_ctx, bf16* H, const float* gain, const float* modL, int sh_off, int sc_off, int lane, int w, int nw, const float* part = nullptr) {
    constexpr int nrows = SEL == 1 ? MLAT : NB * LCTX;
    if (w < 0 || w >= nrows) return;
    f32x4 gv[4];
#pragma unroll
    for (int j = 0; j < 4; ++j) gv[j] = *(const f32x4*)(gain + 4 * lane + 256 * j);
    v2u nb[2][4]; f32x4 nf[2][4];
#define MRP_LOAD(q_, row_) do { const int rr_ = (row_) < nrows ? (row_) : w; _Pragma("unroll") for (int j = 0; j < 4; ++j) { \
        if (SEL == 1) nb[q_][j] = *(const v2u*)(src_lat + (size_t)rr_ * DM + 4 * lane + 256 * j); else nf[q_][j] = *(const f32x4*)(src_ctx + (size_t)rr_ * DM + 4 * lane + 256 * j); } } while (0)
    MRP_LOAD(0, w); MRP_LOAD(1, w + nw);
    for (int r = w; r < nrows; r += 2 * nw) {
        f32x4 v[2][4]; float ss[2] = {0.f, 0.f}; int rq[2] = {r, (r + nw) < nrows ? (r + nw) : r}; const bool has1 = (r + nw) < nrows;
#pragma unroll
        for (int q = 0; q < 2; ++q)
#pragma unroll
            for (int j = 0; j < 4; ++j) { if (SEL == 1) v[q][j] = (f32x4){bflo(nb[q][j].x), bfhi(nb[q][j].x), bflo(nb[q][j].y), bfhi(nb[q][j].y)}; else v[q][j] = nf[q][j]; }
        MRP_LOAD(0, r + 2 * nw); MRP_LOAD(1, r + 3 * nw);
#pragma unroll
        for (int q = 0; q < 2; ++q)
#pragma unroll
            for (int j = 0; j < 4; ++j) {
                if (SEL == 2 && part != nullptr) v[q][j] = (v[q][j] + *(const f32x4*)(part + (size_t)rq[q] * DM + 4 * lane + 256 * j)) + *(const f32x4*)(part + (size_t)(NB * LCTX + rq[q]) * DM + 4 * lane + 256 * j);
                ss[q] += (v[q][j][0] * v[q][j][0] + v[q][j][1] * v[q][j][1]) + (v[q][j][2] * v[q][j][2] + v[q][j][3] * v[q][j][3]); }
#pragma unroll
        for (int o = 1; o < 64; o <<= 1) { const float t0 = __shfl_xor(ss[0], o), t1 = __shfl_xor(ss[1], o); ss[0] += t0; ss[1] += t1; }
#pragma unroll
        for (int q = 0; q < 2; ++q) { if (q == 1 && !has1) break;
            int cond, hrow; const int rr = rq[q];
            if (SEL == 1) { const int b = rr >> 13; cond = b; hrow = b * TT + LCTX + (rr & (SEQ - 1)); } else { const int b = rr >> 8; cond = 4; hrow = b * TT + (rr & (LCTX - 1)); }
            const float* mp = modL + cond * 6144;
            const float rstd = 1.0f / sqrtf(ss[q] * (1.0f / DM) + NORM_EPS);
#pragma unroll
            for (int j = 0; j < 4; ++j) { const f32x4 sh = *(const f32x4*)(mp + sh_off + 4 * lane + 256 * j), sc = *(const f32x4*)(mp + sc_off + 4 * lane + 256 * j);
                const f32x4 y = v[q][j] * rstd * gv[j] * (sc + 1.0f) + sh; v2u wv; wv.x = pk2(y[0], y[1]); wv.y = pk2(y[2], y[3]);
                *(v2u*)(H + (size_t)hrow * DM + 4 * lane + 256 * j) = wv; } }
    }
#undef MRP_LOAD
}

__device__ __forceinline__ void s_phase(const Args& a, LAS unsigned char* lds, int tid, int lane, int wave) {
    unsigned char* ws = launder_ptr(a.ws);
    const bf16* BCRAW = (const bf16*)(ws + R_BCRAW); const bf16* RQ = (const bf16*)(ws + R_RQ); const bf16* RK = (const bf16*)(ws + R_RK);
    bf16* CMC = (bf16*)(ws + R_CMC); bf16* Sg = (bf16*)(ws + R_S); bf16* KTg = (bf16*)(ws + R_KT);
    const float* cw = a.in[I_ECONVW]; const float* cb = a.in[I_ECONVB];
    LAS unsigned char* Xq = lds; LAS unsigned char* Xk = lds + 34816;
#ifdef PROBE_T_LO
    unsigned long long tA = 0, tB = 0, tC = 0, tq0 = __builtin_amdgcn_s_memrealtime();
#define SP_TICK(acc) do { const unsigned long long t1_ = __builtin_amdgcn_s_memrealtime(); acc += t1_ - tq0; tq0 = t1_; } while (0)
#else
#define SP_TICK(acc) do {} while (0)
#endif
#define SP_BAR() do { asm volatile("s_waitcnt lgkmcnt(0)" ::: "memory"); __builtin_amdgcn_s_barrier(); asm volatile("" ::: "memory"); } while (0)
    LAS unsigned char* HAL = lds + 69632;
    v4u R[8], Hh = {0u, 0u, 0u, 0u};
#define SP_LOAD(u_) do { const int b_ = (u_) / (NCH * 6), rem_ = (u_) % (NCH * 6), c_ = rem_ / 6, kind_ = rem_ % 6; const int row0_ = b_ * TT + c_ * 128; const int cg_ = tid & 15; \
        _Pragma("unroll") for (int k = 0; k < 4; ++k) { const int s_ = (tid >> 4) + 32 * k; \
            if (kind_ >= 2) { R[k] = *(const v4u*)(RQ + (size_t)(row0_ + s_) * 512 + (kind_ - 2) * 128 + cg_ * 8); R[4 + k] = *(const v4u*)(RK + (size_t)(row0_ + s_) * 512 + (kind_ - 2) * 128 + cg_ * 8); } \
            else { R[k] = *(const v4u*)(BCRAW + (size_t)(row0_ + s_) * 512 + 256 + kind_ * 128 + cg_ * 8); R[4 + k] = *(const v4u*)(BCRAW + (size_t)(row0_ + s_) * 512 + kind_ * 128 + cg_ * 8); } } \
        if (kind_ < 2 && tid < 64) { const int hr_ = tid >> 5, wh_ = (tid >> 4) & 1; const bool ok_ = hr_ ? !(c_ == 1 || c_ == NCH - 1) : !(c_ == 0 || c_ == 2); \
            Hh = (v4u){0u, 0u, 0u, 0u}; if (ok_) Hh = *(const v4u*)(BCRAW + (size_t)(row0_ + (hr_ ? 128 : -1)) * 512 + wh_ * 256 + kind_ * 128 + cg_ * 8); } } while (0)
    if ((int)blockIdx.x < NB * NCH * 6) SP_LOAD((int)blockIdx.x);
    for (int u = blockIdx.x; u < NB * NCH * 6; u += gridDim.x) {
        const int b = u / (NCH * 6), rem = u % (NCH * 6), c = rem / 6, kind = rem % 6; const int row0 = b * TT + c * 128;
        { const int cg = tid & 15;
#pragma unroll
          for (int k = 0; k < 4; ++k) { const int s = (tid >> 4) + 32 * k; *(LAS v4u*)(Xq + s * 272 + cg * 16) = R[k]; *(LAS v4u*)(Xk + s * 272 + cg * 16) = R[4 + k]; }
          if (kind < 2 && tid < 64) *(LAS v4u*)(HAL + tid * 16) = Hh; }
        SP_BAR();
        { const int un = u + (int)gridDim.x; if (un < NB * NCH * 6) SP_LOAD(un); }
        if (kind < 2) {
#pragma unroll
            for (int which = 0; which < 2; ++which) {
                LAS unsigned char* buf = which ? Xq : Xk; const int cg = tid & 15;
                v4u cur[4], prv[4], nxt[4];
#pragma unroll
                for (int k = 0; k < 4; ++k) { const int s = (tid >> 4) + 32 * k; cur[k] = *(const LAS v4u*)(buf + s * 272 + cg * 16);
                    prv[k] = (s > 0) ? *(const LAS v4u*)(buf + (s - 1) * 272 + cg * 16) : *(const LAS v4u*)(HAL + (which * 16 + cg) * 16);
                    nxt[k] = (s < 127) ? *(const LAS v4u*)(buf + (s + 1) * 272 + cg * 16) : *(const LAS v4u*)(HAL + (32 + which * 16 + cg) * 16); }
                SP_BAR();
                const int choff = which * 256 + kind * 128 + cg * 8;
                const float* w0 = cw + 1024 + choff; const float* w1 = w0 + 1536; const float* w2 = w1 + 1536; const float* bb = cb + 1024 + choff;
#pragma unroll
                for (int k = 0; k < 4; ++k) { const int s = (tid >> 4) + 32 * k; float o[8];
#pragma unroll
                    for (int j = 0; j < 4; ++j) {
                        o[2 * j] = silu_f(w0[2 * j] * bflo(prv[k][j]) + w1[2 * j] * bflo(cur[k][j]) + w2[2 * j] * bflo(nxt[k][j]) + bb[2 * j]);
                        o[2 * j + 1] = silu_f(w0[2 * j + 1] * bfhi(prv[k][j]) + w1[2 * j + 1] * bfhi(cur[k][j]) + w2[2 * j + 1] * bfhi(nxt[k][j]) + bb[2 * j + 1]); }
                    v4u w; w.x = pk2(o[0], o[1]); w.y = pk2(o[2], o[3]); w.z = pk2(o[4], o[5]); w.w = pk2(o[6], o[7]);
                    *(LAS v4u*)(buf + s * 272 + cg * 16) = w;
                    if (which) *(v4u*)(CMC + (size_t)(row0 + s) * 256 + kind * 128 + cg * 8) = w; }
            }
            SP_BAR();
        }
        SP_TICK(tA);
#pragma unroll
        for (int k = 0; k < 4; ++k) { const int task = tid + 512 * k, n = task & 127, s8 = task >> 7; unsigned short e[8];
#pragma unroll
            for (int j = 0; j < 8; ++j) e[j] = *(const LAS unsigned short*)(Xk + (s8 * 8 + j) * 272 + n * 2);
            v4u w; w.x = e[0] | ((unsigned)e[1] << 16); w.y = e[2] | ((unsigned)e[3] << 16); w.z = e[4] | ((unsigned)e[5] << 16); w.w = e[6] | ((unsigned)e[7] << 16);
            *(v4u*)(KTg + (size_t)u * 16384 + n * 128 + s8 * 8) = w; }
        SP_TICK(tB);
        const int r = lane & 31, hh = lane >> 5;
#pragma unroll
        for (int tt = 0; tt < 2; ++tt) { const int idx = 2 * wave + tt, tr = idx >> 2, tc = idx & 3; f32x16 acc;
#pragma unroll
            for (int i = 0; i < 16; ++i) acc[i] = 0.f;
#pragma unroll
            for (int ks = 0; ks < 8; ++ks) { const v4u af = *(const LAS v4u*)(Xq + (tr * 32 + r) * 272 + (16 * ks + 8 * hh) * 2), bfr = *(const LAS v4u*)(Xk + (tc * 32 + r) * 272 + (16 * ks + 8 * hh) * 2);
                acc = MFMA32(af, bfr, acc); }
            bf16* sp = Sg + (size_t)u * 16384 + tc * 32 + r;
#pragma unroll
            for (int i = 0; i < 16; ++i) { const int l = tr * 32 + (i & 3) + 8 * (i >> 2) + 4 * hh; sp[l * 128] = (bf16)f2bf(acc[i]); } }
        SP_BAR();
        SP_TICK(tC);
    }
#ifdef PROBE_T_LO
    if (blockIdx.x == 0 && tid == 0) { volatile unsigned long long* st = (volatile unsigned long long*)(ws + WS_CTL + 786432) + 50; st[0] = tA; st[1] = tB; st[2] = tC; }
#endif
#undef SP_TICK
#undef SP_LOAD
#undef SP_BAR
    { const float* LAg = (const float*)(ws + WS_LA); const float* DTg = (const float*)(ws + WS_DT); float* DEC = (float*)(ws + R_DEC);
      for (int it = blockIdx.x * NWAVES + wave; it < NB * NCH * 16; it += gridDim.x * NWAVES) {
        const int head = it & 15, bc = it >> 4; const int row0 = (bc / NCH) * TT + (bc % NCH) * 128; const int l0 = 2 * lane, l1 = l0 + 1;
        const float* lp = LAg + (size_t)(row0 + l0) * 32 + head; const float* dp = DTg + (size_t)(row0 + l0) * 32 + head;
        const float x0 = lp[0] * LOG2E, x1 = lp[32] * LOG2E, y0 = lp[16] * LOG2E, y1 = lp[48] * LOG2E, df0 = dp[0], df1 = dp[32], db0 = dp[16], db1 = dp[48];
        const float sx = x0 + x1, sy = y0 + y1; float ix = sx, iy = sy;
#pragma unroll
        for (int d = 1; d < 64; d <<= 1) { const float tx = __shfl_up(ix, d), ty = __shfl_up(iy, d); if (lane >= d) { ix += tx; iy += ty; } }
        const float totx = __shfl(ix, 63), toty = __shfl(iy, 63); const float ex = ix - sx, ey = iy - sy;
        const float af0 = ex + x0, af1 = ex + sx, ab0 = toty - ey, ab1 = toty - ey - y0;
        float* o = DEC + (size_t)it * DEC_STRIDE + l0;
        *(f32x2*)(o) = (f32x2){af0, af1}; *(f32x2*)(o + 128) = (f32x2){ab0, ab1};
        *(f32x2*)(o + 256) = (f32x2){af0 - __log2f(df0), af1 - __log2f(df1)}; *(f32x2*)(o + 384) = (f32x2){ab0 - __log2f(db0), ab1 - __log2f(db1)};
        *(f32x2*)(o + 512) = (f32x2){df0 * fast_exp2(totx - af0), df1 * fast_exp2(totx - af1)}; *(f32x2*)(o + 640) = (f32x2){db0 * fast_exp2(toty - ab0), db1 * fast_exp2(toty - ab1)};
        if (lane == 0) *(f32x4*)(DEC + (size_t)it * DEC_STRIDE + 768) = (f32x4){fast_exp2(totx), fast_exp2(toty), 0.f, 0.f};
      } }
}

#define LDS_BARRIER() do { asm volatile("s_waitcnt lgkmcnt(0)" ::: "memory"); __builtin_amdgcn_s_barrier(); asm volatile("" ::: "memory"); } while (0)
struct ScanLane { unsigned qlane, klane, slane, vlane, ylane, y16, dlane, wlane; int b, qld2; float dskip; };
template <bool FWD, bool ISRET> __device__ __forceinline__ void scan_pass(const ARG_AS unsigned char* ws, ARG_AS unsigned char* wsw, LAS unsigned char* lds, const ScanLane& L, int tid, int lane, int wave) {
    LAS unsigned char* VT = lds; LAS unsigned char* HB = lds + 8704;
    LAS float* AF = (LAS float*)(lds + 26112); LAS float* AB = AF + 128; LAS float* AFM = AF + 256; LAS float* ABM = AF + 384; LAS float* SC = AF + 768; LAS float* CW = AF + 784;
    LAS unsigned char* VTW = lds + 32768;
    LAS float* CT = (LAS float*)(lds + 32768 + 8704);
    LAS float* YT = (LAS float*)(lds + 49152);
    const LAS float* AX = FWD ? AF : AB; const LAS float* WVX = AF + (FWD ? 512 : 640);
    const int fr = lane & 15, fq = lane >> 4, b = L.b;
    const int frp0 = (fr & 8) + (((fr & 7) + 2 * (fr >> 3)) & 7), frp1 = 16 + (fr & 8) + (((fr & 7) + 4 + 2 * (fr >> 3)) & 7);
    f32x4 hacc[2]; hacc[0] = (f32x4){0.f, 0.f, 0.f, 0.f}; hacc[1] = hacc[0];
    for (int i = tid; i < 2 * 32 * 136 / 2; i += NTHR) ((LAS unsigned*)HB)[i] = 0u;
    v4u cq[4], cs[4], cvc, cvx, cdec; float cw; v4u cyb = {0u, 0u, 0u, 0u}; unsigned prow0 = 0u;
    v4u nq[4], ns[4], nvc, nvx, ndec; float nw;
    const unsigned dclamp = L.dlane - (tid > 192 ? (unsigned)(tid - 192) * 16u : 0u);
#define SCAN_CHUNK(step_) (FWD ? (step_) : ((step_) == 0 ? 1 : ((step_) == 1 ? 0 : NCH + 1 - (step_))))
#define SCAN_LOAD(step_, Q, S_, VC, VX, DEC_, W_) do { const int c_ = SCAN_CHUNK(step_); const unsigned row0_ = (unsigned)(b * TT + c_ * 128); \
        const ARG_AS unsigned char* qb_ = ws + (size_t)(row0_ * (unsigned)L.qld2); const ARG_AS unsigned char* tb_ = ws + (size_t)((unsigned)((b * NCH + c_) * 6) * 32768u); \
        const ARG_AS unsigned char* vb_ = ws + (size_t)(row0_ * 2048u); const ARG_AS unsigned char* db_ = ws + (size_t)((unsigned)((b * NCH + c_) * 16) * (unsigned)(DEC_STRIDE * 4)); \
        _Pragma("unroll") for (int k = 0; k < 4; ++k) { Q[k] = *(const ARG_AS v4u*)(qb_ + (L.qlane + 64u * k)); if (FWD) S_[k] = *(const ARG_AS v4u*)(tb_ + (L.slane + 64u * k)); } \
        VC = *(const ARG_AS v4u*)(vb_ + L.vlane); \
        if (!ISRET) { const int s_ = tid >> 2; const bool zp_ = (s_ == 0) && (c_ == 0 || c_ == 2), zn_ = (s_ == 127) && (c_ == 1 || c_ == NCH - 1); \
            const bool up_ = lane < 4 && !zp_, dn_ = lane >= 60 && !zn_; const v4u t_ = *(const ARG_AS v4u*)(vb_ + (up_ ? L.vlane - 2048u : (dn_ ? L.vlane + 2048u : L.vlane))); \
            const unsigned keep_ = (up_ || dn_) ? 0xffffffffu : 0u; VX = (v4u){t_.x & keep_, t_.y & keep_, t_.z & keep_, t_.w & keep_}; \
            DEC_ = *(const ARG_AS v4u*)(db_ + dclamp); W_ = *(const ARG_AS float*)(db_ + (L.wlane + (FWD ? 0u : 512u))); } } while (0)
    SCAN_LOAD(0, cq, cs, cvc, cvx, cdec, cw);
    __syncthreads();
    for (int step = 0; step < NCH; ++step) {
        const int c = SCAN_CHUNK(step);
        const unsigned row0 = (unsigned)(b * TT + c * 128);
        LAS unsigned char* HBc = HB + (step & 1) * 8704; LAS unsigned char* HBn = HB + ((step + 1) & 1) * 8704;
        if (!ISRET) { if (tid < 193) *(LAS v4u*)(AF + tid * 4) = cdec; }
        { const int s = tid >> 2, pg = tid & 3; float o[8];
            if (ISRET) {
#pragma unroll
                for (int j = 0; j < 4; ++j) { o[2 * j] = bflo(cvc[j]); o[2 * j + 1] = bfhi(cvc[j]); }
            } else {
                v4u cvp, cvn;
#pragma unroll
                for (int j = 0; j < 4; ++j) { const unsigned up = (unsigned)__shfl_up((int)cvc[j], 4), dn = (unsigned)__shfl_down((int)cvc[j], 4); cvp[j] = lane < 4 ? cvx[j] : up; cvn[j] = lane >= 60 ? cvx[j] : dn; }
                const LAS float* w0 = CW + pg * 8; const LAS float* w1 = w0 + 32; const LAS float* w2 = w0 + 64; const LAS float* bb = w0 + 96;
#pragma unroll
                for (int j = 0; j < 4; ++j) {
                    o[2 * j] = silu_f(w0[2 * j] * bflo(cvp[j]) + w1[2 * j] * bflo(cvc[j]) + w2[2 * j] * bflo(cvn[j]) + bb[2 * j]);
                    o[2 * j + 1] = silu_f(w0[2 * j + 1] * bfhi(cvp[j]) + w1[2 * j + 1] * bfhi(cvc[j]) + w2[2 * j + 1] * bfhi(cvn[j]) + bb[2 * j + 1]); } }
            const float wv = ISRET ? WVX[s] : cw;
#pragma unroll
            for (int j = 0; j < 4; ++j) { const unsigned pa = pkc(o[2 * j], o[2 * j + 1]), pw = pkc(o[2 * j] * wv, o[2 * j + 1] * wv);
                const int r0_ = pg * 8 + ((2 * j + 2 * pg) & 7), r1_ = pg * 8 + ((2 * j + 1 + 2 * pg) & 7);
                *(LAS unsigned short*)(VT + r0_ * 272 + s * 2) = (unsigned short)pa; *(LAS unsigned short*)(VT + r1_ * 272 + s * 2) = (unsigned short)(pa >> 16);
                *(LAS unsigned short*)(VTW + r0_ * 272 + s * 2) = (unsigned short)pw; *(LAS unsigned short*)(VTW + r1_ * 272 + s * 2) = (unsigned short)(pw >> 16); } }
        if (step > 0) { const int yr = tid >> 2, yc = (tid & 3) * 8; float yv[8];
#pragma unroll
            for (int q = 0; q < 8; ++q) yv[q] = YT[yr * 33 + yc + q];
            if (FWD) { yv[0] += bflo(cyb.x); yv[1] += bfhi(cyb.x); yv[2] += bflo(cyb.y); yv[3] += bfhi(cyb.y); yv[4] += bflo(cyb.z); yv[5] += bfhi(cyb.z); yv[6] += bflo(cyb.w); yv[7] += bfhi(cyb.w); }
            v4u o4; o4.x = pkc(yv[0], yv[1]); o4.y = pkc(yv[2], yv[3]); o4.z = pkc(yv[4], yv[5]); o4.w = pkc(yv[6], yv[7]);
            *(ARG_AS v4u*)(wsw + (size_t)(prow0 * 4096u) + L.y16) = o4; }
        LDS_BARRIER();
        if (FWD) cyb = *(const ARG_AS v4u*)(ws + (size_t)(row0 * 4096u) + L.y16);
        prow0 = row0;
        v4u ck[4];
        { const ARG_AS unsigned char* tb = ws + (size_t)((unsigned)((b * NCH + c) * 6) * 32768u);
#pragma unroll
          for (int k = 0; k < 4; ++k) ck[k] = *(const ARG_AS v4u*)(tb + (L.klane + 64u * k)); }
        { const int sn = step + 1 < NCH ? step + 1 : step; SCAN_LOAD(sn, nq, ns, nvc, nvx, ndec, nw); }
#define VFR(base, pb, k) (*(const LAS v4u*)((base) + ((pb) ? frp1 : frp0) * 272 + (32 * (k) + 8 * fq) * 2))
        { const float at = SC[FWD ? 0 : 1]; hacc[0] = hacc[0] * at; hacc[1] = hacc[1] * at;
#pragma unroll
            for (int k = 0; k < 4; ++k) { const v4u v0 = VFR(VTW, 0, k), v1 = VFR(VTW, 1, k); hacc[0] = MFMA16(v0, ck[k], hacc[0]); hacc[1] = MFMA16(v1, ck[k], hacc[1]); }
#pragma unroll
            for (int pb = 0; pb < 2; ++pb)
#pragma unroll
                for (int e = 0; e < 4; e += 2) { const unsigned pk = pkc(hacc[pb][e], hacc[pb][e + 1]);
                    *(LAS unsigned short*)(HBn + (pb * 16 + 4 * fq + e) * 272 + (wave * 16 + fr) * 2) = (unsigned short)pk; *(LAS unsigned short*)(HBn + (pb * 16 + 4 * fq + e + 1) * 272 + (wave * 16 + fr) * 2) = (unsigned short)(pk >> 16); } }
        f32x4 yacc[2]; yacc[0] = (f32x4){0.f, 0.f, 0.f, 0.f}; yacc[1] = yacc[0];
#pragma unroll
        for (int pb = 0; pb < 2; ++pb)
#pragma unroll
            for (int k = 0; k < 4; ++k) { const v4u hf = *(const LAS v4u*)(HBc + (pb * 16 + fr) * 272 + (32 * k + 8 * fq) * 2); yacc[pb] = MFMA16(cq[k], hf, yacc[pb]); }
        { const f32x4 av = *(const LAS f32x4*)(AX + wave * 16 + 4 * fq);
#pragma unroll
            for (int e = 0; e < 4; ++e) { const float sc = fast_exp2(av[e]); yacc[0][e] *= sc; yacc[1][e] *= sc; } }
        if (FWD) { const int l = wave * 16 + fr; const float afl = AF[l], abl = AB[l];
            const int kd = wave >> 1;
#pragma unroll
            for (int k = 0; k < 4; ++k) { const int s0 = 32 * k + 8 * fq; float m[8];
                if (k < kd) { const f32x4 fa0 = *(const LAS f32x4*)(AFM + s0), fa1 = *(const LAS f32x4*)(AFM + s0 + 4);
#pragma unroll
                    for (int e = 0; e < 8; ++e) { const unsigned wsv = cs[k][e >> 1]; const float sv = (e & 1) ? bfhi(wsv) : bflo(wsv); m[e] = sv * fast_exp2(afl - (e < 4 ? fa0[e & 3] : fa1[e & 3])); }
                } else if (k > kd) { const f32x4 ba0 = *(const LAS f32x4*)(ABM + s0), ba1 = *(const LAS f32x4*)(ABM + s0 + 4);
#pragma unroll
                    for (int e = 0; e < 8; ++e) { const unsigned wsv = cs[k][e >> 1]; const float sv = (e & 1) ? bfhi(wsv) : bflo(wsv); m[e] = sv * fast_exp2(abl - (e < 4 ? ba0[e & 3] : ba1[e & 3])); }
                } else { const int thr = l - s0;
                    const f32x4 fa0 = *(const LAS f32x4*)(AFM + s0), fa1 = *(const LAS f32x4*)(AFM + s0 + 4), ba0 = *(const LAS f32x4*)(ABM + s0), ba1 = *(const LAS f32x4*)(ABM + s0 + 4);
#pragma unroll
                    for (int e = 0; e < 8; ++e) { const float afs = e < 4 ? fa0[e & 3] : fa1[e & 3], abs_ = e < 4 ? ba0[e & 3] : ba1[e & 3];
                        const unsigned wsv = cs[k][e >> 1]; const float sv = (e & 1) ? bfhi(wsv) : bflo(wsv);
                        const float arg = (thr >= e) ? afl - afs : abl - abs_;
                        m[e] = sv * fast_exp2(arg); }
                    if (thr >= 0 && thr < 8) {
                        const unsigned w01 = (thr & 4) ? ((thr & 2) ? cs[k].w : cs[k].z) : ((thr & 2) ? cs[k].y : cs[k].x); const float sd = (thr & 1) ? bfhi(w01) : bflo(w01);
                        CT[l] = sd * fast_exp2(abl - ABM[l]) + L.dskip; } }
                v4u mf; mf.x = pkc(m[0], m[1]); mf.y = pkc(m[2], m[3]); mf.z = pkc(m[4], m[5]); mf.w = pkc(m[6], m[7]);
                { const v4u v0 = VFR(VT, 0, k), v1 = VFR(VT, 1, k); yacc[0] = MFMA16(mf, v0, yacc[0]); yacc[1] = MFMA16(mf, v1, yacc[1]); } __builtin_amdgcn_sched_barrier(0); }
            const f32x4 cv = *(const LAS f32x4*)(CT + wave * 16 + 4 * fq);
#pragma unroll
            for (int pb = 0; pb < 2; ++pb) { const v2u vv = *(const LAS v2u*)(VT + (pb ? frp1 : frp0) * 272 + (wave * 16 + 4 * fq) * 2);
                yacc[pb][0] += cv[0] * bflo(vv.x); yacc[pb][1] += cv[1] * bfhi(vv.x); yacc[pb][2] += cv[2] * bflo(vv.y); yacc[pb][3] += cv[3] * bfhi(vv.y); } }
#pragma unroll
        for (int pb = 0; pb < 2; ++pb)
#pragma unroll
            for (int e = 0; e < 4; ++e) YT[(wave * 16 + 4 * fq + e) * 33 + pb * 16 + fr] = yacc[pb][e];
        LDS_BARRIER();
#pragma unroll
        for (int k = 0; k < 4; ++k) { cq[k] = nq[k]; if (FWD) cs[k] = ns[k]; }
        cvc = nvc; if (!ISRET) { cvx = nvx; cdec = ndec; cw = nw; }
    }
#undef VFR
#undef SCAN_LOAD
#undef SCAN_CHUNK
    { const int yr = tid >> 2, yc = (tid & 3) * 8; float yv[8];
#pragma unroll
      for (int q = 0; q < 8; ++q) yv[q] = YT[yr * 33 + yc + q];
      if (FWD) { yv[0] += bflo(cyb.x); yv[1] += bfhi(cyb.x); yv[2] += bflo(cyb.y); yv[3] += bfhi(cyb.y); yv[4] += bflo(cyb.z); yv[5] += bfhi(cyb.z); yv[6] += bflo(cyb.w); yv[7] += bfhi(cyb.w); }
      v4u o4; o4.x = pkc(yv[0], yv[1]); o4.y = pkc(yv[2], yv[3]); o4.z = pkc(yv[4], yv[5]); o4.w = pkc(yv[6], yv[7]);
      *(ARG_AS v4u*)(wsw + (size_t)(prow0 * 4096u) + L.y16) = o4; }
    asm volatile("s_waitcnt vmcnt(0)" ::: "memory");
    __syncthreads();
}
__device__ __forceinline__ void scan_phase(const Args& a, LAS unsigned char* lds, int tid, int lane, int wave) {
    ARG_AS unsigned char* wsw = launder_ptr(a.ws); const ARG_AS unsigned char* ws = wsw;
    LAS float* AF = (LAS float*)(lds + 26112); LAS float* AB = AF + 128; LAS float* AFM = AF + 256; LAS float* ABM = AF + 384; LAS float* SC = AF + 768; LAS float* CW = AF + 784;
    const int fr = lane & 15, fq = lane >> 4;
    for (int sid = blockIdx.x; sid < 256; sid += gridDim.x) {
        const int xq = sid & 7, jq = sid >> 3; const int b = xq >> 1; const bool isret = jq >= 16;
        const int head = isret ? 2 * (xq & 1) + ((jq - 16) >> 3) : (xq & 1) * 8 + (jq >> 1), ps = isret ? ((jq - 16) & 7) : (jq & 1);
        const int kind = isret ? 2 + head : (head >> 3);
        const int vcol = isret ? head * 256 + ps * 32 : head * 64 + ps * 32;
        const int ycol = isret ? 1024 + head * 256 + ps * 32 : head * 64 + ps * 32;
        const int qld = isret ? 512 : 256;
        ScanLane L;
        L.qlane = (unsigned)(isret ? R_RQ + head * 256 : R_CMC + (head >> 3) * 256) + (unsigned)((wave * 16 + fr) * qld + 8 * fq) * 2u;
        L.klane = (unsigned)R_KT + (unsigned)((wave * 16 + fr) * 128 + 8 * fq) * 2u + (unsigned)kind * 32768u;
        L.slane = (unsigned)R_S + (unsigned)((wave * 16 + fr) * 128 + 8 * fq) * 2u + (unsigned)kind * 32768u;
        L.vlane = (unsigned)(isret ? R_RV : R_XS) + (unsigned)((tid >> 2) * 1024 + vcol + (tid & 3) * 8) * 2u;
        L.ylane = (unsigned)R_Y + (unsigned)((wave * 16 + 4 * fq) * 2048 + ycol + fr) * 2u;
        L.y16 = (unsigned)R_Y + (unsigned)((tid >> 2) * 2048 + ycol + (tid & 3) * 8) * 2u;
        L.dlane = (unsigned)R_DEC + (unsigned)head * (unsigned)(DEC_STRIDE * 4) + (unsigned)tid * 16u;
        L.wlane = (unsigned)R_DEC + (unsigned)head * (unsigned)(DEC_STRIDE * 4) + (unsigned)(512 + (tid >> 2)) * 4u;
        L.b = b; L.qld2 = qld * 2; L.dskip = isret ? 0.f : a.in[I_ED][head];
        __syncthreads();
        if (tid < 128) { const int k = tid >> 5, p = tid & 31; const int ch = vcol + p; CW[tid] = isret ? 0.f : (k < 3 ? a.in[I_ECONVW][k * 1536 + ch] : a.in[I_ECONVB][ch]); }
        if (isret && tid < 128) {
            const float lamf = -__expf(a.in[I_ERETD][head]) * LOG2E, lamb = -__expf(a.in[I_ERETD][4 + head]) * LOG2E; const float l = (float)tid;
            AF[tid] = (l + 1.f) * lamf; AB[tid] = (128.f - l) * lamb; AFM[tid] = (l + 1.f) * lamf; ABM[tid] = (128.f - l) * lamb; AF[512 + tid] = fast_exp2((127.f - l) * lamf); AF[640 + tid] = fast_exp2(l * lamb);
            if (tid == 0) { SC[0] = fast_exp2(128.f * lamf); SC[1] = fast_exp2(128.f * lamb); } }
        if (isret) { scan_pass<false, true>(ws, wsw, lds, L, tid, lane, wave); scan_pass<true, true>(ws, wsw, lds, L, tid, lane, wave); }
        else { scan_pass<false, false>(ws, wsw, lds, L, tid, lane, wave); scan_pass<true, false>(ws, wsw, lds, L, tid, lane, wave); }
    }
    if (gridDim.x == 256 && blockIdx.x >= 128) { __syncthreads(); dense_weight_convert(a, lds, lane, wave, DENSE_W_EARLY, DENSE_W_TOTAL, ((int)blockIdx.x - 128) * NWAVES + wave, 128 * NWAVES); }
}

__device__ __forceinline__ void finish_phase(const Args& a, int lane, int sel, int w, int nw) {
    unsigned char* ws = launder_ptr(a.ws); bf16* Y = (bf16*)(ws + R_Y); const float* gn = a.in[I_ESSDN];
    if (w < 0) return;
    const int nrows = sel == 1 ? MLAT : NB * LCTX;
    v4u pY[2], pZ[2], pR[2], pG[2];
#define FIN_ADDR(r_, row_, Z_, RG_) const int row_ = sel == 1 ? ((r_) >> 13) * TT + LCTX + ((r_) & (SEQ - 1)) : ((r_) >> 8) * TT + ((r_) & (LCTX - 1)); \
        const bf16* Z_ = sel == 1 ? (const bf16*)(ws + R_Z) + (size_t)row_ * 1024 : (const bf16*)(ws + R_ZC) + (size_t)(r_) * 1024; \
        const bf16* RG_ = sel == 1 ? (const bf16*)(ws + R_RG) + (size_t)row_ * 1024 : (const bf16*)(ws + R_RGC) + (size_t)(r_) * 1024;
#define FIN_LOAD(r_) do { FIN_ADDR(r_, row_n, Z_n, RG_n) const bf16* yr_n = Y + (size_t)row_n * 2048; \
        _Pragma("unroll") for (int j = 0; j < 2; ++j) { const int idx = 8 * lane + 512 * j; pY[j] = *(const v4u*)(yr_n + idx); pZ[j] = *(const v4u*)(Z_n + idx); pR[j] = *(const v4u*)(yr_n + 1024 + idx); pG[j] = *(const v4u*)(RG_n + idx); } } while (0)
    if (w < nrows) FIN_LOAD(w);
    for (int r = w; r < nrows; r += nw) {
        FIN_ADDR(r, row, Z, RG) (void)Z; (void)RG;
        bf16* yr = Y + (size_t)row * 2048;
        v4u cY[2], cZ[2], cR[2], cG[2];
#pragma unroll
        for (int j = 0; j < 2; ++j) { cY[j] = pY[j]; cZ[j] = pZ[j]; cR[j] = pR[j]; cG[j] = pG[j]; }
        { const int rn = (r + nw) < nrows ? (r + nw) : r; FIN_LOAD(rn); }
        float v[2][8]; float ss = 0.f;
#pragma unroll
        for (int j = 0; j < 2; ++j) { const v4u yv = cY[j], zv = cZ[j];
#pragma unroll
            for (int q = 0; q < 4; ++q) { const float a0 = bflo(yv[q]) * silu_f(bflo(zv[q])), a1 = bfhi(yv[q]) * silu_f(bfhi(zv[q])); v[j][2 * q] = a0; v[j][2 * q + 1] = a1; ss += a0 * a0 + a1 * a1; } }
        const float rstd = 1.0f / sqrtf(wave_sum(ss) * (1.0f / 1024.0f) + NORM_EPS);
#pragma unroll
        for (int j = 0; j < 2; ++j) { const int idx = 8 * lane + 512 * j; const f32x4 g0 = *(const f32x4*)(gn + idx), g1 = *(const f32x4*)(gn + idx + 4); v4u w;
            w.x = pk2(v[j][0] * rstd * g0[0], v[j][1] * rstd * g0[1]); w.y = pk2(v[j][2] * rstd * g0[2], v[j][3] * rstd * g0[3]);
            w.z = pk2(v[j][4] * rstd * g1[0], v[j][5] * rstd * g1[1]); w.w = pk2(v[j][6] * rstd * g1[2], v[j][7] * rstd * g1[3]); *(v4u*)(yr + idx) = w; }
#pragma unroll
        for (int j = 0; j < 2; ++j) { const int idx = 8 * lane + 512 * j; const v4u yv = cR[j], gv = cG[j];
            float y8[8]; float s2 = 0.f;
#pragma unroll
            for (int q = 0; q < 4; ++q) { y8[2 * q] = bflo(yv[q]); y8[2 * q + 1] = bfhi(yv[q]); s2 += y8[2 * q] * y8[2 * q] + y8[2 * q + 1] * y8[2 * q + 1]; }
#pragma unroll
            for (int o = 1; o < 32; o <<= 1) s2 += __shfl_xor(s2, o);
            const float rs = 1.0f / sqrtf(s2 * (1.0f / 256.0f) + NORM_EPS); v4u w;
            w.x = pk2(y8[0] * rs * silu_f(bflo(gv[0])), y8[1] * rs * silu_f(bfhi(gv[0]))); w.y = pk2(y8[2] * rs * silu_f(bflo(gv[1])), y8[3] * rs * silu_f(bfhi(gv[1])));
            w.z = pk2(y8[4] * rs * silu_f(bflo(gv[2])), y8[5] * rs * silu_f(bfhi(gv[2]))); w.w = pk2(y8[6] * rs * silu_f(bflo(gv[3])), y8[7] * rs * silu_f(bfhi(gv[3])));
            *(v4u*)(yr + 1024 + idx) = w; }
    }
#undef FIN_LOAD
#undef FIN_ADDR
}

__device__ __forceinline__ void glds16s(const void* sbase, unsigned voff, unsigned lds_dst) {
    unsigned keep;
    asm volatile("s_mov_b32 %0, m0\n\ts_mov_b32 m0, %3\n\ts_nop 0\n\tglobal_load_lds_dwordx4 %1, %2\n\ts_mov_b32 m0, %0" : "=&s"(keep) : "v"(voff), "s"(sbase), "s"(lds_dst) : "memory");
}
__device__ __forceinline__ float rowsum16(float acc, const f32x16& x) {
    asm volatile("s_nop 1\n\tv_add_f32 %0, %0, %1\n\tv_add_f32 %0, %0, %2\n\tv_add_f32 %0, %0, %3\n\tv_add_f32 %0, %0, %4\n\tv_add_f32 %0, %0, %5\n\tv_add_f32 %0, %0, %6\n\tv_add_f32 %0, %0, %7\n\tv_add_f32 %0, %0, %8\n\t"
                 "v_add_f32 %0, %0, %9\n\tv_add_f32 %0, %0, %10\n\tv_add_f32 %0, %0, %11\n\tv_add_f32 %0, %0, %12\n\tv_add_f32 %0, %0, %13\n\tv_add_f32 %0, %0, %14\n\tv_add_f32 %0, %0, %15\n\tv_add_f32 %0, %0, %16"
                 : "+v"(acc) : "v"(x[0]), "v"(x[1]), "v"(x[2]), "v"(x[3]), "v"(x[4]), "v"(x[5]), "v"(x[6]), "v"(x[7]), "v"(x[8]), "v"(x[9]), "v"(x[10]), "v"(x[11]), "v"(x[12]), "v"(x[13]), "v"(x[14]), "v"(x[15]));
    return acc;
}
#ifndef ATT_REPS
#define ATT_REPS 1
#endif
#ifndef ATT_G0
#define ATT_G0 0
#endif
#ifndef ATT_PRIO
#define ATT_PRIO 0
#endif
#ifndef ATT_NSLOT
#define ATT_NSLOT 3
#endif
__device__ __forceinline__ void attn_phase(const Args& a, LAS unsigned char* lds, int tid, int lane, int wave) {
    unsigned char* ws = launder_ptr(a.ws);
    const bf16* Qg = (const bf16*)(ws + R_Q); const bf16* Kg = (const bf16*)(ws + R_K); const bf16* Vt = (const bf16*)(ws + R_VT); bf16* Og = (bf16*)(ws + R_O);
    const float* scal = (const float*)(ws + WS_SCAL); const float lam = scal[0];
    const float* subln = a.in[I_OSUBLN];
    constexpr int BUF = 32768, NT = TT / 64, NBLK = TT / 32;
    const int r = lane & 31, hh = lane >> 5;
    const int G = gridDim.x;
    const int rho = (lane & ~12) | ((lane & 4) << 1) | ((lane & 8) >> 1);
    const unsigned klane = (unsigned)rho * 2048u + (unsigned)wave * 32u, vlane = (unsigned)lane * (unsigned)(MROWS * 2) + (unsigned)wave * 16u;
#define ATT_BAR() do { asm volatile("" ::: "memory"); __builtin_amdgcn_s_barrier(); asm volatile("" ::: "memory"); } while (0)
    for (int it = 0;; ++it) {
        const long L0 = (long)it * G + blockIdx.x; if (L0 >= 1024 * ATT_REPS) break;
        const long L = L0 & 1023;
        const int pair = (int)(L & 7) + 8 * (int)(L >> 8), qb = (int)((L & 255) >> 3); const int b = pair >> 3, h = pair & 7;
        const size_t qrow = (size_t)b * TT + LCTX + qb * 256 + wave * 32 + r;
        v4u qf[2][4];
#pragma unroll
        for (int sub = 0; sub < 2; ++sub)
#pragma unroll
            for (int ks = 0; ks < 4; ++ks) qf[sub][ks] = *(const v4u*)(Qg + qrow * 1024 + h * 128 + sub * 64 + ks * 16 + hh * 8);
        f32x16 o1[4], o2[4];
#pragma unroll
        for (int vb = 0; vb < 4; ++vb)
#pragma unroll
            for (int i = 0; i < 16; ++i) { o1[vb][i] = 0.f; o2[vb][i] = 0.f; }
        float l1 = 0.f, l2 = 0.f;
        const char* kub = (const char*)(Kg + (size_t)b * TT * 1024 + h * 128);
        const char* vub = (const char*)(Vt + (size_t)(h * 128) * MROWS + (size_t)b * TT);
#define ATT_STAGE(slot, kt) do { const char* kp_ = kub + (size_t)(kt) * (64 * 1024 * 2); const char* vp_ = vub + (size_t)(kt) * 128; const unsigned lb_ = (unsigned)(size_t)lds + (unsigned)(slot) * (unsigned)BUF + (unsigned)wave * 2048u; \
        glds16s(kp_, klane, lb_); glds16s(kp_ + 16, klane, lb_ + 1024u); glds16s(vp_, vlane, lb_ + 16384u); glds16s(vp_ + (size_t)64 * MROWS * 2, vlane, lb_ + 16384u + 1024u); } while (0)
        asm volatile("s_waitcnt vmcnt(0)" ::: "memory");
        __syncthreads();
#pragma unroll
        for (int sub = 0; sub < 2; ++sub)
#pragma unroll
            for (int ks = 0; ks < 4; ++ks) asm volatile("" : "+v"(qf[sub][ks]));
        ATT_STAGE(0, 0); ATT_STAGE(1, 1); if (ATT_NSLOT == 4) ATT_STAGE(2, 2);
        if (ATT_NSLOT == 4) asm volatile("s_waitcnt vmcnt(8)" ::: "memory"); else asm volatile("s_waitcnt vmcnt(0)" ::: "memory");
        ATT_BAR();
        f32x16 s1, s2; v4u pfc[2][2], pfn[2][2];
#pragma unroll
        for (int u0 = 0; u0 < 2; ++u0)
#pragma unroll
            for (int u1 = 0; u1 < 2; ++u1) { pfc[u0][u1] = (v4u){0u, 0u, 0u, 0u}; pfn[u0][u1] = (v4u){0u, 0u, 0u, 0u}; }
        v4u kf[4];
        { LAS unsigned char* kb0 = lds + hh * 1024 + r * 16;
          kf[0] = *(const LAS v4u*)(kb0); kf[1] = *(const LAS v4u*)(kb0 + 8192); kf[2] = *(const LAS v4u*)(kb0 + 2048); kf[3] = *(const LAS v4u*)(kb0 + 8192 + 2048); }
#if ATT_PRIO == 1
        if (wave >= 4) __builtin_amdgcn_s_setprio(1);
#endif
#pragma unroll 1
        for (int j = 0; j < NBLK; ++j) {
            const int jp = j > 0 ? j - 1 : 0, jn = j + 1 < NBLK ? j + 1 : NBLK - 1;
            LAS unsigned char* kbuf = lds + ((j >> 1) % ATT_NSLOT) * BUF + hh * 1024 + ((j & 1) * 32 + r) * 16;
            LAS unsigned char* knx = lds + ((jn >> 1) % ATT_NSLOT) * BUF + hh * 1024 + ((jn & 1) * 32 + r) * 16;
            LAS unsigned char* vbuf = lds + ((jp >> 1) % ATT_NSLOT) * BUF + 16384 + (jp & 1) * 8192 + hh * 2048 + r * 16;
            v4u af;
#if ATT_PRIO == 2
            __builtin_amdgcn_s_setprio(1);
#endif
#if ATT_PRIO == 3
            __builtin_amdgcn_s_setprio(0);
#endif
            {
#pragma unroll
              for (int i = 0; i < 16; ++i) { s1[i] = 0.f; s2[i] = 0.f; }
              s1 = MFMA32(kf[0], qf[0][0], s1); kf[0] = *(const LAS v4u*)(kbuf + 2 * 2048);
              s2 = MFMA32(kf[1], qf[1][0], s2); kf[1] = *(const LAS v4u*)(kbuf + 8192 + 2 * 2048);
              s1 = MFMA32(kf[2], qf[0][1], s1); kf[2] = *(const LAS v4u*)(kbuf + 3 * 2048);
              s2 = MFMA32(kf[3], qf[1][1], s2); kf[3] = *(const LAS v4u*)(kbuf + 8192 + 3 * 2048);
              af = *(const LAS v4u*)(vbuf);
              s1 = MFMA32(kf[0], qf[0][2], s1); s2 = MFMA32(kf[1], qf[1][2], s2); s1 = MFMA32(kf[2], qf[0][3], s1); s2 = MFMA32(kf[3], qf[1][3], s2); }
            __builtin_amdgcn_sched_barrier(0);
#if ATT_PRIO == 2
            __builtin_amdgcn_s_setprio(0);
#endif
#if ATT_PRIO == 3
            __builtin_amdgcn_s_setprio(1);
#endif
            { float e0 = 0.f, e1 = 0.f, f0 = 0.f, f1 = 0.f;
#pragma unroll
              for (int g = 0; g < 8; ++g) { const int vb = g & 3, st = g >> 2; v4u afn = af;
                  if (g < 7) { const int g1 = g + 1, vb1 = g1 & 3, st1 = g1 >> 2; afn = *(const LAS v4u*)(vbuf + st1 * 4096 + (vb1 >> 1) * 1024 + (vb1 & 1) * 512); }
                  if (g >= 4) { const int q = g - 4; kf[q] = *(const LAS v4u*)(knx + (q & 1) * 8192 + (q >> 1) * 2048); }
                  if (g > 0) asm volatile("v_add_f32 %0, %0, %2\n\tv_add_f32 %1, %1, %3\n\tv_add_f32 %0, %0, %4\n\tv_add_f32 %1, %1, %5" : "+v"(l1), "+v"(l2) : "v"(e0), "v"(f0), "v"(e1), "v"(f1));
                  o1[vb] = MFMA32(af, pfc[0][st], o1[vb]);
                  if (ATT_G0 && g == 0) { o2[vb] = MFMA32(af, pfc[1][st], o2[vb]); __builtin_amdgcn_sched_barrier(0);
                      e0 = fast_exp2(s1[2 * g]); e1 = fast_exp2(s1[2 * g + 1]); }
                  else { e0 = fast_exp2(s1[2 * g]); e1 = fast_exp2(s1[2 * g + 1]);
                      o2[vb] = MFMA32(af, pfc[1][st], o2[vb]); }
                  f0 = fast_exp2(s2[2 * g]); f1 = fast_exp2(s2[2 * g + 1]);
                  pfn[0][g >> 2][g & 3] = pkc(e0, e1); pfn[1][g >> 2][g & 3] = pkc(f0, f1);
                  af = afn;
                  __builtin_amdgcn_sched_barrier(0); }
              asm volatile("v_add_f32 %0, %0, %2\n\tv_add_f32 %1, %1, %3\n\tv_add_f32 %0, %0, %4\n\tv_add_f32 %1, %1, %5" : "+v"(l1), "+v"(l2) : "v"(e0), "v"(f0), "v"(e1), "v"(f1)); }
#pragma unroll
            for (int u0 = 0; u0 < 2; ++u0)
#pragma unroll
                for (int u1 = 0; u1 < 2; ++u1) pfc[u0][u1] = pfn[u0][u1];
            if (!(j & 1)) { const int T = j >> 1;
                if (ATT_NSLOT == 4 && T + 2 < NT) asm volatile("s_waitcnt vmcnt(4)" ::: "memory"); else asm volatile("s_waitcnt vmcnt(0)" ::: "memory");
                ATT_BAR();
                if (T + ATT_NSLOT - 1 < NT) ATT_STAGE((T + ATT_NSLOT - 1) % ATT_NSLOT, T + ATT_NSLOT - 1); }
        }
#if ATT_PRIO == 1
        __builtin_amdgcn_s_setprio(0);
#endif
        { const int jp = NBLK - 1; LAS unsigned char* vbuf = lds + ((jp >> 1) % ATT_NSLOT) * BUF + 16384 + (jp & 1) * 8192 + hh * 2048 + r * 16;
#pragma unroll
          for (int g = 0; g < 8; ++g) { const int vb = g & 3, st = g >> 2; const v4u af = *(const LAS v4u*)(vbuf + st * 4096 + (vb >> 1) * 1024 + (vb & 1) * 512);
              o1[vb] = MFMA32(af, pfc[0][st], o1[vb]); o2[vb] = MFMA32(af, pfc[1][st], o2[vb]); } }
#undef ATT_STAGE
        l1 += __shfl_xor(l1, 32); l2 += __shfl_xor(l2, 32);
        const float i1 = 1.0f / l1, i2 = lam / l2; float ss = 0.f;
#pragma unroll
        for (int vb = 0; vb < 4; ++vb)
#pragma unroll
            for (int i = 0; i < 16; ++i) { const float o = o1[vb][i] * i1 - o2[vb][i] * i2; o1[vb][i] = o; ss += o * o; }
        ss += __shfl_xor(ss, 32);
        const float rstd = (1.0f - LAM_INIT) / sqrtf(ss * (1.0f / 128.0f) + NORM_EPS);
        bf16* orow = Og + ((size_t)b * SEQ + qb * 256 + wave * 32 + r) * 1024 + h * 128;
#pragma unroll
        for (int vb = 0; vb < 4; ++vb) { v2u pg[4];
#pragma unroll
            for (int g = 0; g < 4; ++g) { const int e = vb * 32 + 8 * g + 4 * hh; const f32x4 sg = *(const f32x4*)(subln + e);
                pg[g].x = pk2(o1[vb][4 * g] * rstd * sg[0], o1[vb][4 * g + 1] * rstd * sg[1]); pg[g].y = pk2(o1[vb][4 * g + 2] * rstd * sg[2], o1[vb][4 * g + 3] * rstd * sg[3]); }
            const v2u sx = hh ? pg[0] : pg[2], sy = hh ? pg[1] : pg[3]; v2u rx, ry;
            rx.x = (unsigned)__shfl_xor((int)sx.x, 32); rx.y = (unsigned)__shfl_xor((int)sx.y, 32); ry.x = (unsigned)__shfl_xor((int)sy.x, 32); ry.y = (unsigned)__shfl_xor((int)sy.y, 32);
            v4u w1, w2;
            if (hh) { w1 = (v4u){rx.x, rx.y, pg[2].x, pg[2].y}; w2 = (v4u){ry.x, ry.y, pg[3].x, pg[3].y}; } else { w1 = (v4u){pg[0].x, pg[0].y, rx.x, rx.y}; w2 = (v4u){pg[1].x, pg[1].y, ry.x, ry.y}; }
            *(v4u*)(orow + vb * 32 + 16 * hh) = w1; *(v4u*)(orow + vb * 32 + 16 * hh + 8) = w2; }
    }
#undef ATT_BAR
}

__device__ __forceinline__ void route_phase(const Args& a, LAS unsigned char* lds, int tid, int lane, int wave) {
    unsigned char* ws = launder_ptr(a.ws); bf16* H = (bf16*)(ws + WS_H); const float* gain = a.in[I_ONORM2]; const float* modL = (const float*)(ws + WS_MOD) + 5 * 6144; const float* router = a.in[I_OROUTER];
    int* toke = (int*)(ws + WS_TOKE); int* tokr = (int*)(ws + WS_TOKR); float* tokw = (float*)(ws + WS_TOKW); unsigned* cnt = (unsigned*)(ws + WS_CTL) + CW_CNT;
    int* slott = (int*)(ws + WS_SLOTT);
    for (int i = blockIdx.x * NTHR + tid; i < 2 * MOE_TILES * 256; i += gridDim.x * NTHR) slott[i] = -1;
    LAS int* le = (LAS int*)lds;
    const int G = gridDim.x, chunk = (MLAT + G - 1) / G;
    const int t0 = blockIdx.x * chunk, t1 = (t0 + chunk) < MLAT ? (t0 + chunk) : MLAT;
    LAS float* RT = (LAS float*)(lds + 4096);
    { f32x4 r4[2048 / NTHR];
#pragma unroll
      for (int k = 0; k < 2048 / NTHR; ++k) r4[k] = *(const f32x4*)(router + 4 * (tid + k * NTHR));
#pragma unroll
      for (int k = 0; k < 2048 / NTHR; ++k) { const int i = tid + k * NTHR, d = i >> 1, e = (i & 1) * 4;
          RT[(e + 0) * 1024 + d] = r4[k][0]; RT[(e + 1) * 1024 + d] = r4[k][1]; RT[(e + 2) * 1024 + d] = r4[k][2]; RT[(e + 3) * 1024 + d] = r4[k][3]; } }
    __syncthreads();
    f32x4 gv[4];
#pragma unroll
    for (int j = 0; j < 4; ++j) gv[j] = *(const f32x4*)(gain + 4 * lane + 256 * j);
    const bf16* XB = (const bf16*)(a.out + (size_t)MLAT * DM / 2);
    v2u vn[4];
    { const bf16* src0 = XB + (size_t)((t0 + wave) < t1 ? (t0 + wave) : t0) * DM;
#pragma unroll
      for (int j = 0; j < 4; ++j) vn[j] = *(const v2u*)(src0 + 4 * lane + 256 * j); }
    for (int row = t0 + wave; row < t1; row += NWAVES) {
        const float* mp = modL + (row >> 13) * 6144;
        f32x4 v[4]; float ss = 0.f;
#pragma unroll
        for (int j = 0; j < 4; ++j) { v[j] = (f32x4){bflo(vn[j].x), bfhi(vn[j].x), bflo(vn[j].y), bfhi(vn[j].y)}; ss += (v[j][0] * v[j][0] + v[j][1] * v[j][1]) + (v[j][2] * v[j][2] + v[j][3] * v[j][3]); }
        { const int rn = (row + NWAVES) < t1 ? (row + NWAVES) : row; const bf16* srcn = XB + (size_t)rn * DM;
#pragma unroll
          for (int j = 0; j < 4; ++j) vn[j] = *(const v2u*)(srcn + 4 * lane + 256 * j); }
        const float rstd = 1.0f / sqrtf(wave_sum(ss) * (1.0f / DM) + NORM_EPS);
        float lg[8] = {0.f, 0.f, 0.f, 0.f, 0.f, 0.f, 0.f, 0.f};
#pragma unroll
        for (int j = 0; j < 4; ++j) { const f32x4 sh = *(const f32x4*)(mp + 3072 + 4 * lane + 256 * j), sc = *(const f32x4*)(mp + 4096 + 4 * lane + 256 * j);
            const f32x4 y = v[j] * rstd * gv[j] * (sc + 1.0f) + sh; v2u w; w.x = pk2(y[0], y[1]); w.y = pk2(y[2], y[3]);
            *(v2u*)(H + (size_t)row * DM + 4 * lane + 256 * j) = w;
#pragma unroll
            for (int e = 0; e < 8; ++e) { const f32x4 r4 = *(const LAS f32x4*)(RT + e * 1024 + 4 * lane + 256 * j); lg[e] += (y[0] * r4[0] + y[1] * r4[1]) + (y[2] * r4[2] + y[3] * r4[3]); } }
        { const bool b5 = lane & 32, b4 = lane & 16, b3 = lane & 8; float a4[4], a2[2], a1;
#pragma unroll
          for (int q = 0; q < 4; ++q) { const float mine = b5 ? lg[4 + q] : lg[q], theirs = b5 ? lg[q] : lg[4 + q]; a4[q] = mine + __shfl_xor(theirs, 32); }
#pragma unroll
          for (int q = 0; q < 2; ++q) { const float mine = b4 ? a4[2 + q] : a4[q], theirs = b4 ? a4[q] : a4[2 + q]; a2[q] = mine + __shfl_xor(theirs, 16); }
          { const float mine = b3 ? a2[1] : a2[0], theirs = b3 ? a2[0] : a2[1]; a1 = mine + __shfl_xor(theirs, 8); }
          a1 += __shfl_xor(a1, 4); a1 += __shfl_xor(a1, 2); a1 += __shfl_xor(a1, 1);
#pragma unroll
          for (int e = 0; e < 8; ++e) lg[e] = __builtin_bit_cast(float, __builtin_amdgcn_readlane(__builtin_bit_cast(int, a1), e * 8)); }
        int e0 = 0; float v0 = lg[0];
#pragma unroll
        for (int e = 1; e < 8; ++e) if (lg[e] > v0) { v0 = lg[e]; e0 = e; }
        int e1 = -1; float v1 = -3.0e38f;
#pragma unroll
        for (int e = 0; e < 8; ++e) if (e != e0 && lg[e] > v1) { v1 = lg[e]; e1 = e; }
        if (lane == 0) { const float w0 = 1.0f / (1.0f + __expf(v1 - v0));
            le[row - t0] = e0; le[chunk + row - t0] = e1; toke[row] = e0; toke[MLAT + row] = e1; tokw[row] = w0; tokw[MLAT + row] = 1.0f - w0; }
    }
    __syncthreads();
    { const int grp = tid >> 5, l32 = tid & 31, p = grp >> 3, e = grp & 7; const int n = t1 - t0; const unsigned below = (1u << l32) - 1u; int c = 0;
      for (int j = 0; j * 32 < n; ++j) { const int i = l32 + 32 * j; const bool f = (i < n) && (le[p * chunk + i] == e);
          const unsigned long long m = __ballot(f); const unsigned half = (tid & 32) ? (unsigned)(m >> 32) : (unsigned)m; c += __popc(half); }
      int base = 0; if (l32 == 0 && c > 0) base = (int)__hip_atomic_fetch_add(cnt + 64 * (p * 8 + e), (unsigned)c, RLX_AGENT);
      base = __shfl(base, tid & 32); int run = 0;
      for (int j = 0; j * 32 < n; ++j) { const int i = l32 + 32 * j; const bool f = (i < n) && (le[p * chunk + i] == e);
          const unsigned long long m = __ballot(f); const unsigned half = (tid & 32) ? (unsigned)(m >> 32) : (unsigned)m;
          if (f) tokr[p * MLAT + t0 + i] = base + run + __popc(half & below); run += __popc(half); } }
    __syncthreads();
}
__device__ __forceinline__ void slot_phase(const Args& a, int tid) {
    unsigned char* ws = launder_ptr(a.ws); unsigned* cnt = (unsigned*)(ws + WS_CTL) + CW_CNT; int* meta = (int*)(ws + WS_META);
    const int* toke = (const int*)(ws + WS_TOKE); const int* tokr = (const int*)(ws + WS_TOKR); const float* tokw = (const float*)(ws + WS_TOKW);
    int* slott = (int*)(ws + WS_SLOTT); float* slotw = (float*)(ws + WS_SLOTW);
    int b0[8], b1[8]; int nt0, nt1;
    { int acc = 0;
#pragma unroll
      for (int e = 0; e < 8; ++e) { b0[e] = acc; const int c = (int)__hip_atomic_load(cnt + 64 * e, RLX_AGENT); acc += (c + 255) & ~255; } nt0 = acc >> 8; acc = 0;
#pragma unroll
      for (int e = 0; e < 8; ++e) { b1[e] = acc; const int c = (int)__hip_atomic_load(cnt + 64 * (8 + e), RLX_AGENT); acc += (c + 255) & ~255; } nt1 = acc >> 8; }
    if (blockIdx.x == 0) {
        if (tid < 2) meta[16 + tid] = tid ? nt1 : nt0;
        for (int i = tid; i < 2 * MOE_TILES; i += NTHR) { const int p = i / MOE_TILES, tile = i % MOE_TILES; int e = 0;
#pragma unroll
            for (int q = 1; q < 8; ++q) if (tile * 256 >= (p ? b1[q] : b0[q])) e = q;
            meta[32 + i] = e; }
    }
    for (int t = blockIdx.x * NTHR + tid; t < MLAT; t += gridDim.x * NTHR) {
        { const int e = toke[t]; int bs = 0;
#pragma unroll
          for (int q = 0; q < 8; ++q) if (q == e) bs = b0[q];
          const int slot = bs + tokr[t]; slott[slot] = t; slotw[slot] = tokw[t]; }
        { const int e = toke[MLAT + t]; int bs = 0;
#pragma unroll
          for (int q = 0; q < 8; ++q) if (q == e) bs = b1[q];
          const int slot = bs + tokr[MLAT + t]; slott[MOE_TILES * 256 + slot] = t; slotw[MOE_TILES * 256 + slot] = tokw[MLAT + t]; }
    }
}


constexpr int N_PHASES = 23;
constexpr int MOE_CVT_A = (MOE_CVT_ITEMS / 5) & ~15, MOE_CVT_C = (MOE_CVT_ITEMS * 2 / 5) & ~15;
constexpr int LDS_BYTES = 147456;
constexpr int MISC_OFF = 131072 + 1024;

template <unsigned MASK> __global__ void __launch_bounds__(NTHR, 2) hybrid_fwd(Args args) {
    extern __shared__ __attribute__((aligned(16))) unsigned char lds_raw[];
    LAS unsigned char* lds = (LAS unsigned char*)lds_raw;
    volatile LAS unsigned* MISC = (volatile LAS unsigned*)(lds + MISC_OFF);
    unsigned* ctl = (unsigned*)(args.ws + WS_CTL);
    if (threadIdx.x < 32) MISC[threadIdx.x] = 0u;
    __syncthreads();
    const int lo = args.ph_lo, hi = args.ph_hi;
    const bool use_bar = (hi - lo) > 1;
    XcdBarrier bar; bar.bar = ctl + CW_BAR; bar.x = 0; bar.st = nullptr;
    if (use_bar) bar = xcd_barrier_post(ctl + CW_BAR, MISC + 8);
#define IN(k) (((MASK >> (k)) & 1u) && lo <= (k) && (k) < hi)
#ifdef PROBE_T_LO
#define STAMP(k) do { if (blockIdx.x == 0 && threadIdx.x == 0) ((volatile unsigned long long*)(args.ws + WS_CTL + 786432))[k] = __builtin_amdgcn_s_memrealtime(); } while (0)
#else
#define STAMP(k) do {} while (0)
#endif
#define SEAM(k) do { if (IN(k) && IN((k) + 1)) xcd_barrier(bar); STAMP((k) + 1); } while (0)
    const int G = gridDim.x, cid = blockIdx.x;
#define PHASE_PTRS int tid = threadIdx.x; asm volatile("" : "+v"(tid)); const int lane = tid & 63, wave = __builtin_amdgcn_readfirstlane(tid >> 6); (void)lane; (void)wave; unsigned char* ws = launder_ptr(args.ws); float* mod0 = (float*)(ws + WS_MOD); float* mod1 = mod0 + 5 * 6144; const float* gz0 = args.zgate ? (const float*)(ws + WS_CTL + 524288) : mod0; const float* gz1 = args.zgate ? (const float*)(ws + WS_CTL + 524288) : mod1; (void)gz0; (void)gz1; bf16* H = (bf16*)(ws + WS_H); float* XC = (float*)(ws + WS_XC); bf16* XB = (bf16*)(args.out + (size_t)MLAT * DM / 2); (void)XB; (void)mod0; (void)mod1; (void)H; (void)XC

    STAMP(0);
    if (IN(0)) { PHASE_PTRS; p0_prologue(args, lds, tid, lane, wave); } SEAM(0);
    if (IN(1)) { PHASE_PTRS; mod_rows<true>(args.in[I_X], args.in[I_CTX], H, args.in[I_ENORM1], mod0, 0, 1024, lane, wave, XC); p0_weights(args, lds, tid, lane, wave); } SEAM(1);
    if (IN(2)) { PHASE_PTRS;
        pg8::Gemm g{H, (const bf16*)(ws + WS_WINA), MROWS, NA_TILES * 256, 1024}; pg8::StaticOrder S; S.init(MROWS, NA_TILES * 256, G, cid);
        EpiInA E{(bf16*)(ws + R_XS), (bf16*)(ws + R_BCRAW), (bf16*)(ws + R_RQ), (bf16*)(ws + R_RK), (bf16*)(ws + R_RV), (float*)(ws + WS_DT), (float*)(ws + WS_LA),
                 (const float*)(ws + WS_ROPERET), args.in[I_EDTB], args.in[I_EALOG]};
        pg8::gemm_phase<EpiInA, pg8::StaticOrder, true, false>(lds, g, S, E, nullptr);
        { pg8::Gemm g2{H, (const bf16*)(ws + WS_WINB), MROWS, 2048, 1024}; pg8::LatCtxOrder S2; S2.init(G, (cid + G - (132 * NA_TILES) % G) % G, 1024 / 64, 2, 8);
          EpiStore E2{(bf16*)(ws + R_ZC), (bf16*)(ws + R_RGC), 4, 1024, 1024, 33};
          pg8::gemm_phase<EpiStore, pg8::LatCtxOrder, true, false>(lds, g2, S2, E2, nullptr); }
    } SEAM(2);
    if (IN(3)) { PHASE_PTRS; s_phase(args, lds, tid, lane, wave); } SEAM(3);
    if (IN(4)) { PHASE_PTRS; scan_phase(args, lds, tid, lane, wave); } SEAM(4);
    if (IN(5)) { PHASE_PTRS;
        finish_phase(args, lane, 2, cid * NWAVES + wave, G * NWAVES);
        pg8::Gemm g{H, (const bf16*)(ws + WS_WINB), MROWS, 2048, 1024}; pg8::LatCtxOrder S; S.init(G, cid, 1024 / 64, 0, 8);
        EpiStore E{(bf16*)(ws + R_Z), (bf16*)(ws + R_RG), 4, 1024, 1024};
        pg8::gemm_phase<EpiStore, pg8::LatCtxOrder, true, false>(lds, g, S, E, nullptr);
    } SEAM(5);
    if (IN(6)) { PHASE_PTRS;
        { pg8::Gemm g{(const bf16*)(ws + R_Y), (const bf16*)(ws + WS_WOUT0), MROWS, 1024, 2048}; pg8::LatCtxOrder S; S.init(G, cid, 2048 / 64, 2);
          EpiResB<true> E{args.in[I_X], XB, XC, gz0 + 2048};
          pg8::gemm_phase<EpiResB<true>, pg8::LatCtxOrder, true, false>(lds, g, S, E, nullptr); }
        { const int nb = G > 32 ? 16 : 0; finish_phase(args, lane, 1, cid >= nb ? (cid - nb) * NWAVES + wave : -1, (G - nb) * NWAVES); }
    } SEAM(6);
    if (IN(7)) { PHASE_PTRS;
        pg8::Gemm g{(const bf16*)(ws + R_Y), (const bf16*)(ws + WS_WOUT0), MROWS, 1024, 2048}; pg8::LatCtxOrder S; S.init(G, cid, 2048 / 64, 0);
        EpiResB<true> E{args.in[I_X], XB, XC, gz0 + 2048};
        pg8::gemm_phase<EpiResB<true>, pg8::LatCtxOrder, true, false>(lds, g, S, E, nullptr);
    } SEAM(7);
    if (IN(8)) { PHASE_PTRS; mod_rows_part<1>(XB, XC, H, args.in[I_ENORM2], mod0, 3072, 4096, lane, cid * NWAVES + wave, G * NWAVES); mod_rows_part<2>(XB, XC, H, args.in[I_ENORM2], mod0, 3072, 4096, lane, cid * NWAVES + wave, G * NWAVES); } SEAM(8);
    if (IN(9)) { PHASE_PTRS;
        pg8::Gemm g{H, (const bf16*)(ws + WS_WGU0), MROWS, 5632, 1024}; pg8::StaticOrder S; S.init(MROWS, 5632, G, cid);
        EpiSwiglu E{(bf16*)(ws + R_HID), FFD, 0, 0};
        pg8::gemm_phase<EpiSwiglu, pg8::StaticOrder, true, false>(lds, g, S, E, nullptr);
        if (G == 256) { const int r = (MROWS / 256 * 22) % G; __syncthreads(); moe_weight_convert(args, lds, lane, wave, 0, MOE_CVT_A, cid >= r ? (cid - r) * NWAVES + wave : -1, (G - r) * NWAVES); }
    } SEAM(9);
    if (IN(10)) { PHASE_PTRS;
        pg8::Gemm g{(const bf16*)(ws + R_HID), (const bf16*)(ws + WS_WDN0), MROWS, 1024, FFD}; pg8::LatCtxOrder S; S.init(G, cid, FFD / 64, 0);
        EpiResB<true> E{nullptr, XB, XC, gz0 + 5120};
        pg8::gemm_phase<EpiResB<true>, pg8::LatCtxOrder, true, false>(lds, g, S, E, nullptr);
    } SEAM(10);
    if (IN(11)) { PHASE_PTRS;
        { pg8::Gemm g{(const bf16*)(ws + R_HID), (const bf16*)(ws + WS_WDN0), MROWS, 1024, FFD}; pg8::LatCtxOrder S; S.init(G, cid, FFD / 64, 3);
          EpiCtxPart E{(float*)(ws + R_CTXPART), gz0 + 5120};
          pg8::gemm_phase<EpiCtxPart, pg8::LatCtxOrder, true, false>(lds, g, S, E, nullptr); }
        { const int nb = G > 64 ? 32 : 0; const int wk = cid >= nb ? (cid - nb) * NWAVES + wave : -1, nwk = (G - nb) * NWAVES;
          mod_rows_part<1>(XB, XC, H, args.in[I_ONORM1], mod1, 0, 1024, lane, wk, nwk);
          moe_weight_convert(args, lds, lane, wave, G == 256 ? MOE_CVT_C : 0, MOE_CVT_ITEMS, wk, nwk); }
    } SEAM(11);
    if (IN(12)) { PHASE_PTRS; mod_rows_part<2>(XB, XC, H, args.in[I_ONORM1], mod1, 0, 1024, lane, cid * NWAVES + wave, G * NWAVES, (const float*)(ws + R_CTXPART)); } SEAM(12);
    if (IN(13)) { PHASE_PTRS;
        { pg8::Gemm g{H, (const bf16*)(ws + WS_WQK), MROWS, 2048, 1024}; pg8::StaticOrder S; S.init(MROWS, 2048, G, cid);
          EpiQK E{(bf16*)(ws + R_Q), (bf16*)(ws + R_K), args.in[I_OQN], args.in[I_OKN], (const float*)(ws + WS_ROPER), (const float*)(ws + WS_ROPEC)};
          pg8::gemm_phase<EpiQK, pg8::StaticOrder, true, false>(lds, g, S, E, nullptr); }
        { pg8::Gemm g{(const bf16*)(ws + WS_WV), H, 1024, MROWS, 1024}; pg8::StaticOrder S; S.init(1024, MROWS, G, (cid + G - 32 % G) % G);
          EpiStore E{(bf16*)(ws + R_VT), (bf16*)(ws + R_VT), 1 << 30, MROWS, MROWS};
          pg8::gemm_phase<EpiStore, pg8::StaticOrder, true, false>(lds, g, S, E, nullptr); }
        if (G == 256) { __syncthreads(); moe_weight_convert(args, lds, lane, wave, MOE_CVT_A, MOE_CVT_C, cid >= 48 ? (cid - 48) * NWAVES + wave : -1, (G - 48) * NWAVES); }
    } SEAM(13);
    if (IN(14)) { PHASE_PTRS; attn_phase(args, lds, tid, lane, wave); } SEAM(14);
    if (IN(15)) { PHASE_PTRS;
        pg8::Gemm g{(const bf16*)(ws + R_O), (const bf16*)(ws + WS_WO1), MLAT, 1024, 1024}; pg8::StaticOrder S; S.init(MLAT, 1024, G, cid);
        EpiResB<false> E{nullptr, XB, nullptr, gz1 + 2048};
        pg8::gemm_phase<EpiResB<false>, pg8::StaticOrder, true, false>(lds, g, S, E, nullptr);
    } SEAM(15);
    if (IN(16)) { PHASE_PTRS; route_phase(args, lds, tid, lane, wave); } SEAM(16);
    if (IN(17)) { PHASE_PTRS; slot_phase(args, tid); } SEAM(17);
    {
        constexpr int HCAP = 4;
        if (IN(18)) { PHASE_PTRS; const int* meta = (const int*)(ws + WS_META); const int* slott = (const int*)(ws + WS_SLOTT);
            pg8::Gemm g{H, (const bf16*)(ws + R_MOEGU), 0, 0, 1024}; pg8::MoeOrder S; S.init(meta[16], 28, G, cid, meta + 32, 0, 0, 0, 0);
            EpiSwiglu E{(bf16*)(ws + R_HID2), FFE, 28, 0};
            pg8::gemm_phase<EpiSwiglu, pg8::MoeOrder, true, true>(lds, g, S, E, slott);
            { const int u0 = meta[16] * 28, rot = u0 % G; const int* slott1 = slott + MOE_TILES * 256;
              pg8::MoeOrder S1; S1.init(meta[17] - 128, 28, G, (cid + G - rot) % G, meta + 32 + MOE_TILES, 128, 8, 0, 0);
              EpiSwiglu E1{(bf16*)(ws + R_HID2), FFE, 28, 8};
              pg8::gemm_phase<EpiSwiglu, pg8::MoeOrder, true, true>(lds, g, S1, E1, slott1); }
        } SEAM(18);
        if (IN(19)) { PHASE_PTRS; const int* meta = (const int*)(ws + WS_META); const int* slott = (const int*)(ws + WS_SLOTT); const float* slotw = (const float*)(ws + WS_SLOTW);
            const int nT = meta[16];
            pg8::Gemm g{(const bf16*)(ws + R_HID2), (const bf16*)(ws + R_MOEDN), 0, 0, FFE}; pg8::MoeOrder S; S.init(nT < 128 ? nT : 128, 4, G, cid, meta + 32, 0, 0, 0, 0);
            EpiMoeDownB E{XB, args.out, gz1 + 5120, slott, slotw, 0};
            pg8::gemm_phase<EpiMoeDownB, pg8::MoeOrder, true, false>(lds, g, S, E, nullptr);
        } SEAM(19);
        if (IN(20)) { PHASE_PTRS; const int* meta = (const int*)(ws + WS_META);
            const int nTa = meta[16], nleft = nTa > 128 ? (nTa - 128) * 4 : 0;
            { const int* slott = (const int*)(ws + WS_SLOTT); const float* slotw = (const float*)(ws + WS_SLOTW);
              pg8::Gemm g{(const bf16*)(ws + R_HID2), (const bf16*)(ws + R_MOEDN), 0, 0, FFE}; pg8::MoeOrder S; S.init(nTa - 128, 4, G, cid, meta + 32, 128, 0, 0, 0);
              EpiMoeDownB E{XB, args.out, gz1 + 5120, slott, slotw, 0};
              pg8::gemm_phase<EpiMoeDownB, pg8::MoeOrder, true, false>(lds, g, S, E, nullptr); }
            const int nTb = meta[17], nleftb = nTb > 128 ? (nTb - 128) * 4 : 0;
            { const int* slott = (const int*)(ws + WS_SLOTT) + MOE_TILES * 256; const float* slotw = (const float*)(ws + WS_SLOTW) + MOE_TILES * 256;
              pg8::Gemm g{(const bf16*)(ws + R_HID2), (const bf16*)(ws + R_MOEDN), 0, 0, FFE}; pg8::MoeOrder S; S.init(nTb - 128, 4, G, (cid + G - nleft % G) % G, meta + 32 + MOE_TILES, 128, 8, 0, 0);
              EpiMoeDownScratch E{(float*)(ws + R_MOESCR), gz1 + 5120, slott, slotw};
              pg8::gemm_phase<EpiMoeDownScratch, pg8::MoeOrder, true, false>(lds, g, S, E, nullptr); }
            { const int* slott = (const int*)(ws + WS_SLOTT) + MOE_TILES * 256;
              pg8::Gemm g{H, (const bf16*)(ws + R_MOEGU), 0, 0, 1024}; pg8::MoeOrder S; S.init(nTb < 128 ? nTb : 128, 28, G, cid, meta + 32 + MOE_TILES, 0, 8, nleft + nleftb, HCAP);
              EpiSwiglu E{(bf16*)(ws + R_HID2), FFE, 28, 8};
              pg8::gemm_phase<EpiSwiglu, pg8::MoeOrder, true, true>(lds, g, S, E, slott); }
        } SEAM(20);
        if (IN(21)) { PHASE_PTRS; const int* meta = (const int*)(ws + WS_META); const int* slott = (const int*)(ws + WS_SLOTT) + MOE_TILES * 256; const float* slotw = (const float*)(ws + WS_SLOTW) + MOE_TILES * 256;
            const int nTb = meta[17];
            pg8::Gemm g{(const bf16*)(ws + R_HID2), (const bf16*)(ws + R_MOEDN), 0, 0, FFE}; pg8::MoeOrder S; S.init(nTb < 128 ? nTb : 128, 4, G, cid, meta + 32 + MOE_TILES, 0, 8, 0, 0);
            EpiMoeDownB E{XB, args.out, gz1 + 5120, slott, slotw, 1};
            pg8::gemm_phase<EpiMoeDownB, pg8::MoeOrder, true, false>(lds, g, S, E, nullptr);
            { const float* scr = (const float*)(ws + R_MOESCR); const int gw = cid * NWAVES + wave, NGW = G * NWAVES;
              for (int s = 128 * 256 + gw; s < nTb * 256; s += NGW) { const int tok = slott[s]; if (tok < 0) continue;
                  bf16* xp = XB + (size_t)tok * DM; float* op = args.out + (size_t)tok * DM; const float* sp = scr + (size_t)(s - 128 * 256) * DM; const bool tof = tok < MLAT / 2;
#pragma unroll
                  for (int j = 0; j < 4; ++j) { const v2u x = *(const v2u*)(xp + 4 * lane + 256 * j); const f32x4 b4 = *(const f32x4*)(sp + 4 * lane + 256 * j);
                      const f32x4 y = (f32x4){bflo(x.x) + b4[0], bfhi(x.x) + b4[1], bflo(x.y) + b4[2], bfhi(x.y) + b4[3]};
                      if (tof) *(f32x4*)(op + 4 * lane + 256 * j) = y; else { v2u o; o.x = pk2(y[0], y[1]); o.y = pk2(y[2], y[3]); *(v2u*)(xp + 4 * lane + 256 * j) = o; } } } }
        } SEAM(21);
        if (IN(22)) { PHASE_PTRS; constexpr int PER = 64;
            for (int base = MLAT / 2; base < MLAT; base += G * PER) { const int r0 = base + cid * PER;
                { v4u t[PER * 128 / NTHR];
#pragma unroll
                  for (int k = 0; k < PER * 128 / NTHR; ++k) { const int i = tid + k * NTHR; const int row = r0 + (i >> 7); t[k] = *(const v4u*)(XB + (size_t)(row < MLAT ? row : MLAT - 1) * DM + (i & 127) * 8); }
#pragma unroll
                  for (int k = 0; k < PER * 128 / NTHR; ++k) { const int i = tid + k * NTHR; *(LAS v4u*)(lds + (size_t)i * 16) = t[k]; } }
                asm volatile("s_waitcnt vmcnt(0) lgkmcnt(0)" ::: "memory");
                if (use_bar) xcd_barrier(bar);
                for (int i = tid; i < PER * 128; i += NTHR) { const int row = r0 + (i >> 7); if (row < MLAT) { const v4u x = *(const LAS v4u*)(lds + (size_t)i * 16); float* fp = args.out + (size_t)row * DM + (i & 127) * 8;
                    *(f32x4*)(fp) = (f32x4){bflo(x.x), bfhi(x.x), bflo(x.y), bfhi(x.y)}; *(f32x4*)(fp + 4) = (f32x4){bflo(x.z), bfhi(x.z), bflo(x.w), bfhi(x.w)}; } }
            }
        }
    }
#ifdef PROBE_T_LO
    STAMP(N_PHASES);
    if (blockIdx.x == 0 && threadIdx.x == 0) { volatile unsigned long long* st = (volatile unsigned long long*)(args.ws + WS_CTL + 786432);
        const unsigned long long dt = st[PROBE_T_HI] - st[PROBE_T_LO], t_end = __builtin_amdgcn_s_memrealtime() + (unsigned long long)PROBE_T_MULT * dt;
        while (__builtin_amdgcn_s_memrealtime() < t_end) __builtin_amdgcn_s_sleep(16); }
#endif
#undef IN
#undef SEAM
}

#ifndef PH_MASK
#define PH_MASK 0x7FFFFFu
#endif
typedef void (*kern_t)(Args);
template <int P> struct KTab { static void fill(kern_t* t) { t[P] = hybrid_fwd<(1u << P)>; KTab<P - 1>::fill(t); } };
template <> struct KTab<-1> { static void fill(kern_t*) {} };
extern "C" void kernel_launch(void* const* d_in, const int* in_sizes, int n_in, void* d_out, int out_size, void* d_ws, size_t ws_size, hipStream_t stream) {
    static int grid = 0;
    static kern_t tab[N_PHASES + 1];
    if (grid == 0) {
        if (n_in != N_IN || out_size != MLAT * DM || ws_size < WS_END) { fprintf(stderr, "kernel_launch: unexpected shapes: n_in %d out %d ws %zu (need %zu)\n", n_in, out_size, ws_size, (size_t)WS_END); grid = -1; return; }
        int dev = 0, cus = 0;
        if (hipGetDevice(&dev) != hipSuccess || hipDeviceGetAttribute(&cus, hipDeviceAttributeMultiprocessorCount, dev) != hipSuccess) { grid = -1; return; }
#if MK_N_LAUNCHES == 1
        tab[N_PHASES] = hybrid_fwd<PH_MASK>;
        if (hipFuncSetAttribute((const void*)tab[N_PHASES], hipFuncAttributeMaxDynamicSharedMemorySize, LDS_BYTES) != hipSuccess) { fprintf(stderr, "kernel_launch: hipFuncSetAttribute failed\n"); grid = -1; return; }
#else
        KTab<N_PHASES - 1>::fill(tab);
        for (int p = 0; p < N_PHASES; ++p) if (hipFuncSetAttribute((const void*)tab[p], hipFuncAttributeMaxDynamicSharedMemorySize, LDS_BYTES) != hipSuccess) { fprintf(stderr, "kernel_launch: hipFuncSetAttribute failed\n"); grid = -1; return; }
#endif
        (void)hipGetLastError();
        grid = cus;
    }
    if (grid < 0) return;
    if (hipMemsetAsync((char*)d_ws + WS_CTL, 0, CTL_BYTES, stream) != hipSuccess) { fprintf(stderr, "kernel_launch: memset failed\n"); return; }
    Args a{};
    for (int i = 0; i < N_IN; ++i) a.in[i] = (const ARG_AS float*)d_in[i];
    a.out = (ARG_AS float*)d_out; a.ws = (ARG_AS unsigned char*)d_ws;
#if MK_N_LAUNCHES == 1
    a.ph_lo = 0; a.ph_hi = N_PHASES;
    hipLaunchKernelGGL(tab[N_PHASES], dim3(grid), dim3(NTHR), LDS_BYTES, stream, a);
#else
#ifndef DUP_MASK
#define DUP_MASK 0u
#endif
    for (int p = 0; p < N_PHASES; ++p) { if (!((PH_MASK >> p) & 1u)) continue; a.ph_lo = p; a.ph_hi = p + 1;
#ifndef DUP_COUNT
#define DUP_COUNT 2
#endif
        for (int rep = 0; rep < (((DUP_MASK >> p) & 1u) ? DUP_COUNT : 1); ++rep) { a.zgate = rep ? 1 : 0; hipLaunchKernelGGL(tab[p], dim3(grid), dim3(NTHR), LDS_BYTES, stream, a); } a.zgate = 0; }
#endif
    const hipError_t le = hipPeekAtLastError();
    if (le != hipSuccess) fprintf(stderr, "kernel_launch: launch failed: %s\n", hipGetErrorName(le));
}
```
